# Optimizing an MI355X kernel written in HIP

```python
import math
import jax
import jax.numpy as jnp
from jax import lax
import numpy as np

D_MODEL = 1024
BATCH = 8
SEQ = 2048
DEPTH = 2
DEC_BATCH = 128
DEC_SEQ = 4
PAST_LEN = 16384
PAGE_SIZE = 128

S5_WIDTH = D_MODEL // 4
S5_GROUP = 16
S5_GROUPS = S5_WIDTH // S5_GROUP
S5_STATE = 64
S5_DT_MIN = 1e-3
S5_DT_MAX = 1e-1
RW_WIDTH = D_MODEL // 2
RW_HEAD = 64
RW_HEADS = RW_WIDTH // RW_HEAD
RW_DECAY_LORA = 32
RW_AAA_LORA = 32
RW_GATE_LORA = 64
RW_COLS = 3 * RW_WIDTH + RW_DECAY_LORA + RW_AAA_LORA + RW_GATE_LORA
RW_SPLITS = (RW_WIDTH, 2 * RW_WIDTH, 3 * RW_WIDTH, 3 * RW_WIDTH + RW_DECAY_LORA,
             3 * RW_WIDTH + RW_DECAY_LORA + RW_AAA_LORA)
RW_GN_EPS = 1e-5 * RW_HEAD
HG_WIDTH = D_MODEL // 4
HG_HEAD = 64
HG_HEADS = HG_WIDTH // HG_HEAD
HG_CHUNK = 16
HG_GATE_FLOOR = 1e-30
N_BRANCH = 3
IN_COLS = S5_WIDTH + RW_COLS + 4 * HG_WIDTH + N_BRANCH * D_MODEL
IN_SPLITS = (S5_WIDTH, S5_WIDTH + RW_COLS, S5_WIDTH + RW_COLS + HG_WIDTH,
             S5_WIDTH + RW_COLS + 2 * HG_WIDTH, S5_WIDTH + RW_COLS + 3 * HG_WIDTH,
             S5_WIDTH + RW_COLS + 4 * HG_WIDTH)
D_FF = 256 * ((8 * D_MODEL // 3 + 255) // 256)
CONV_W = 3
RMS_EPS = 1e-6
F32 = jnp.float32

kernel_name = 'hybrid_s5_rwkv7_hgrn2_convffn_step'


def rms_norm(x, g):
    xf = x.astype(F32)
    return xf * lax.rsqrt(jnp.mean(xf * xf, axis=-1, keepdims=True) + RMS_EPS) * g.astype(F32)


def modulate(x, g, shift, scale):
    return rms_norm(x, g) * (1.0 + scale[:, None, :]) + shift[:, None, :]


def _complex_affine_combine(e1, e2):
    a1r, a1i, b1r, b1i = e1
    a2r, a2i, b2r, b2i = e2
    return (a2r * a1r - a2i * a1i, a2r * a1i + a2i * a1r,
            a2r * b1r - a2i * b1i + b2r, a2r * b1i + a2i * b1r + b2i)


def s5_mixer(u, s_prev, lam_re, lam_im, log_dt, b_re, b_im, c_re, c_im, d_skip, w_glu, b_glu):
    n, l, _ = u.shape
    ug = u.astype(F32).reshape(n, l, S5_GROUPS, S5_GROUP)
    lr = lam_re.astype(F32)
    li = lam_im.astype(F32)
    dt = jnp.exp(log_dt.astype(F32))[:, None]
    mag = jnp.exp(lr * dt)
    ar = mag * jnp.cos(li * dt)
    ai = mag * jnp.sin(li * dt)
    den = lr * lr + li * li
    zr = ((ar - 1.0) * lr + ai * li) / den
    zi = (ai * lr - (ar - 1.0) * li) / den
    bbr = zr[..., None] * b_re - zi[..., None] * b_im
    bbi = zr[..., None] * b_im + zi[..., None] * b_re
    er = jnp.einsum('nlgc,gpc->nlgp', ug, bbr)
    ei = jnp.einsum('nlgc,gpc->nlgp', ug, bbi)
    pr = s_prev[..., 0].astype(F32)
    pi = s_prev[..., 1].astype(F32)
    er = er.at[:, 0].add(ar * pr - ai * pi)
    ei = ei.at[:, 0].add(ar * pi + ai * pr)
    ar_t = jnp.broadcast_to(ar, er.shape)
    ai_t = jnp.broadcast_to(ai, ei.shape)
    _, _, sr, si = lax.associative_scan(_complex_affine_combine, (ar_t, ai_t, er, ei), axis=1)
    y = jnp.einsum('nlgp,gcp->nlgc', sr, c_re) - jnp.einsum('nlgp,gcp->nlgc', si, c_im)
    y = y.reshape(n, l, S5_WIDTH) + d_skip * u
    y = jax.nn.gelu(y)
    y = y * jax.nn.sigmoid(y @ w_glu + b_glu)
    return y, jnp.stack([sr[:, -1], si[:, -1]], axis=-1)


def rwkv7_mixer(p, shift_prev, s_prev, mu, w0, w2, a0, a2, g2, k_k, k_a, r_k, ln_w, ln_b):
    n, l, _ = p.shape
    p = p.astype(F32)
    p_prev = jnp.concatenate([shift_prev[:, None, :].astype(F32), p[:, :-1]], axis=1)
    xm = p + (p_prev - p) * mu
    r, k, v, wd, ad, gd = jnp.split(xm, RW_SPLITS, axis=-1)
    w = -jax.nn.softplus(-(w0 + jnp.tanh(wd) @ w2)) - 0.5
    decay = jnp.exp(-jnp.exp(w))
    a = jax.nn.sigmoid(a0 + ad @ a2)
    g = jax.nn.sigmoid(gd) @ g2

    def hd(t):
        return t.reshape(n, l, RW_HEADS, RW_HEAD)

    kk = hd(k * k_k)
    kk = kk / jnp.maximum(jnp.sqrt(jnp.sum(kk * kk, axis=-1, keepdims=True)), 1e-12)
    k = hd(k * (1.0 + (a - 1.0) * k_a))
    r, v, decay, a = hd(r), hd(v), hd(decay), hd(a)
    seq = tuple(jnp.moveaxis(t, 1, 0) for t in (r, decay, k, v, -kk, kk * a))

    def step(s, inp):
        r_t, w_t, k_t, v_t, a_t, b_t = inp
        sa = jnp.einsum('nhvk,nhk->nhv', s, a_t)
        s = (s * w_t[:, :, None, :] + sa[..., None] * b_t[:, :, None, :]
             + v_t[..., None] * k_t[:, :, None, :])
        return s, jnp.einsum('nhvk,nhk->nhv', s, r_t)

    s_last, y = lax.scan(step, s_prev.astype(F32), seq)
    y = jnp.moveaxis(y, 0, 1)
    mean = jnp.mean(y, axis=-1, keepdims=True)
    var = jnp.mean(jnp.square(y - mean), axis=-1, keepdims=True)
    y = ((y - mean) * lax.rsqrt(var + RW_GN_EPS)).reshape(n, l, RW_WIDTH) * ln_w + ln_b
    bonus = jnp.sum(r * k * r_k, axis=-1, keepdims=True) * v
    y = (y + bonus.reshape(n, l, RW_WIDTH)) * g
    return y, p[:, -1], s_last


def hgrn2_mixer(q, f, i, og, s_prev, lower, norm_g):
    n, l, _ = q.shape
    lower = lower.astype(F32)
    sig_f = jax.nn.sigmoid(f.astype(F32))
    fgate = lower + (1.0 - lower) * sig_f
    log_f = jnp.log(jnp.maximum(fgate, HG_GATE_FLOOR))
    k = 1.0 - fgate
    q = jax.nn.silu(q.astype(F32))
    pad = (-l) % HG_CHUNK
    nc = (l + pad) // HG_CHUNK

    def to_blocks(t):
        t = t.reshape(n, l, HG_HEADS, HG_HEAD)
        t = jnp.pad(t, ((0, 0), (0, pad), (0, 0), (0, 0)))
        return t.reshape(n, nc, HG_CHUNK, HG_HEADS, HG_HEAD).transpose(1, 0, 3, 2, 4)

    causal = jnp.tril(jnp.ones((HG_CHUNK, HG_CHUNK), dtype=bool))[:, :, None]

    def step(s, blk):
        qc, kc, vc, gc = blk
        b = jnp.cumsum(gc, axis=2)
        o_inter = jnp.einsum('nhtk,nhkv->nhtv', qc * jnp.exp(b), s)
        diff = b[:, :, :, None, :] - b[:, :, None, :, :]
        dec = jnp.where(causal, jnp.exp(jnp.where(causal, diff, 0.0)), 0.0)
        att = jnp.einsum('nhtk,nhsk,nhtsk->nhts', qc, kc, dec)
        o_intra = jnp.einsum('nhts,nhsv->nhtv', att, vc)
        b_end = b[:, :, -1]
        s = (jnp.exp(b_end)[..., None] * s
             + jnp.einsum('nhsk,nhsv->nhkv', kc * jnp.exp(b_end[:, :, None, :] - b), vc))
        return s, o_inter + o_intra

    blocks = tuple(to_blocks(t) for t in (q, k, i.astype(F32), log_f))
    s_last, o = lax.scan(step, s_prev.astype(F32), blocks)
    o = o.transpose(1, 0, 3, 2, 4).reshape(n, nc * HG_CHUNK, HG_HEADS, HG_HEAD)[:, :l]
    o = o * lax.rsqrt(jnp.mean(o * o, axis=-1, keepdims=True) + RMS_EPS)
    o = o.reshape(n, l, HG_WIDTH) * norm_g * jax.nn.sigmoid(og)
    return o, s_last


def causal_dwconv(buf, w, b, l):
    out = b + w[0] * buf[:, 0:l]
    for j in range(1, CONV_W):
        out = out + w[j] * buf[:, j:j + l]
    return out


def run_trunk(x, c, st_s5, st_shift, st_rw, st_hg, st_conv, lower, final_g, prm):
    n, l, _ = x.shape
    cs = jax.nn.silu(c.astype(F32))
    h_res = x.astype(F32)
    out_s5, out_shift, out_rw, out_hg, out_conv = [], [], [], [], []
    for layer in range(DEPTH):
        p = {name: arr[layer] for name, arr in prm.items()}
        mod = cs @ p['w_ada'] + p['b_ada']
        sh1, sc1, gt1, sh2, sc2, gt2 = jnp.split(mod, 6, axis=-1)
        h = modulate(h_res, p['g_mix'], sh1, sc1)
        z = h @ p['w_in']
        u_a, p_b, q_c, f_c, i_c, og_c, gate_logits = jnp.split(z, IN_SPLITS, axis=-1)
        y_a, s5_new = s5_mixer(u_a, st_s5[layer], p['s5_lambda_re'], p['s5_lambda_im'],
                               p['s5_log_dt'], p['s5_b_re'], p['s5_b_im'], p['s5_c_re'],
                               p['s5_c_im'], p['s5_d'], p['s5_w_glu'], p['s5_b_glu'])
        y_b, shift_new, rw_new = rwkv7_mixer(p_b, st_shift[layer], st_rw[layer], p['rw_mu'],
                                             p['rw_w0'], p['rw_w2'], p['rw_a0'], p['rw_a2'],
                                             p['rw_g2'], p['rw_k_k'], p['rw_k_a'], p['rw_r_k'],
                                             p['rw_ln_w'], p['rw_ln_b'])
        y_c, hg_new = hgrn2_mixer(q_c, f_c, i_c, og_c, st_hg[layer], lower[layer], p['hg_norm'])
        gates = jax.nn.sigmoid(gate_logits).reshape(n, l, N_BRANCH, D_MODEL)
        merged = (gates[:, :, 0] * (y_a @ p['w_lift_a'])
                  + gates[:, :, 1] * (y_b @ p['w_lift_b'])
                  + gates[:, :, 2] * (y_c @ p['w_lift_c']))
        h_res = h_res + gt1[:, None, :] * (merged @ p['w_out'])
        h2 = modulate(h_res, p['g_ffn'], sh2, sc2)
        up = h2 @ p['w_up']
        buf = jnp.concatenate([st_conv[layer].astype(F32), up], axis=1)
        conv = causal_dwconv(buf, p['conv_w'], p['conv_b'], l)
        a_ff, b_ff = jnp.split(conv, 2, axis=-1)
        h_res = h_res + gt2[:, None, :] * ((jax.nn.gelu(a_ff) * b_ff) @ p['w_down'])
        out_s5.append(s5_new)
        out_shift.append(shift_new)
        out_rw.append(rw_new)
        out_hg.append(hg_new)
        out_conv.append(buf[:, -(CONV_W - 1):])
    y = rms_norm(h_res, final_g).astype(x.dtype)
    return y, (jnp.stack(out_s5), jnp.stack(out_shift), jnp.stack(out_rw),
               jnp.stack(out_hg), jnp.stack(out_conv))


def setup_inputs(seed: int = 0) -> dict:
    keys = iter(jax.random.split(jax.random.key(seed), 64))

    def nrm(shape, std):
        return std * jax.random.normal(next(keys), shape, F32)

    def unif(shape, lo, hi):
        return jax.random.uniform(next(keys), shape, F32, lo, hi)

    L = DEPTH
    d_in = D_MODEL ** -0.5
    n_idx = jnp.arange(S5_STATE, dtype=F32)
    return {
        'x_prompt': nrm((BATCH, SEQ, D_MODEL), 1.0),
        'x_sample': nrm((DEC_BATCH, DEC_SEQ, D_MODEL), 1.0),
        'c_prompt': nrm((BATCH, D_MODEL), 1.0),
        'c_sample': nrm((DEC_BATCH, D_MODEL), 1.0),
        'state_s5': nrm((L, DEC_BATCH, S5_GROUPS, S5_STATE, 2), 0.2),
        'state_rwkv_shift': nrm((L, DEC_BATCH, RW_COLS), 1.0),
        'state_rwkv': nrm((L, DEC_BATCH, RW_HEADS, RW_HEAD, RW_HEAD), 0.3),
        'state_hgrn': nrm((L, DEC_BATCH, HG_HEADS, HG_HEAD, HG_HEAD), 0.5),
        'state_ffn_conv': nrm((L, DEC_BATCH, CONV_W - 1, 2 * D_FF), 1.0),
        'w_ada': nrm((L, D_MODEL, 6 * D_MODEL), 0.5 * d_in),
        'b_ada': nrm((L, 6 * D_MODEL), 0.01),
        'g_mix': 1.0 + nrm((L, D_MODEL), 0.1),
        'g_ffn': 1.0 + nrm((L, D_MODEL), 0.1),
        'w_in': nrm((L, D_MODEL, IN_COLS), d_in),
        's5_lambda_re': -0.5 + nrm((L, S5_GROUPS, S5_STATE), 0.01),
        's5_lambda_im': math.pi * n_idx + nrm((L, S5_GROUPS, S5_STATE), 0.01),
        's5_log_dt': unif((L, S5_GROUPS), math.log(S5_DT_MIN), math.log(S5_DT_MAX)),
        's5_b_re': nrm((L, S5_GROUPS, S5_STATE, S5_GROUP), (2 * S5_GROUP) ** -0.5),
        's5_b_im': nrm((L, S5_GROUPS, S5_STATE, S5_GROUP), (2 * S5_GROUP) ** -0.5),
        's5_c_re': nrm((L, S5_GROUPS, S5_GROUP, S5_STATE), 0.5),
        's5_c_im': nrm((L, S5_GROUPS, S5_GROUP, S5_STATE), 0.5),
        's5_d': nrm((L, S5_WIDTH), 0.5),
        's5_w_glu': nrm((L, S5_WIDTH, S5_WIDTH), S5_WIDTH ** -0.5),
        's5_b_glu': nrm((L, S5_WIDTH), 0.01),
        'rw_mu': unif((L, RW_COLS), 0.0, 1.0),
        'rw_w0': unif((L, RW_WIDTH), -6.0, 1.0),
        'rw_w2': nrm((L, RW_DECAY_LORA, RW_WIDTH), 0.1),
        'rw_a0': nrm((L, RW_WIDTH), 0.5),
        'rw_a2': nrm((L, RW_AAA_LORA, RW_WIDTH), 0.1),
        'rw_g2': nrm((L, RW_GATE_LORA, RW_WIDTH), RW_GATE_LORA ** -0.5),
        'rw_k_k': 0.85 + nrm((L, RW_WIDTH), 0.1),
        'rw_k_a': 1.0 + nrm((L, RW_WIDTH), 0.1),
        'rw_r_k': nrm((L, RW_HEADS, RW_HEAD), 0.1),
        'rw_ln_w': 1.0 + nrm((L, RW_WIDTH), 0.1),
        'rw_ln_b': nrm((L, RW_WIDTH), 0.01),
        'hg_lb': nrm((L, HG_WIDTH), 1.0),
        'hg_norm': 1.0 + nrm((L, HG_WIDTH), 0.1),
        'w_lift_a': nrm((L, S5_WIDTH, D_MODEL), S5_WIDTH ** -0.5),
        'w_lift_b': nrm((L, RW_WIDTH, D_MODEL), RW_WIDTH ** -0.5),
        'w_lift_c': nrm((L, HG_WIDTH, D_MODEL), HG_WIDTH ** -0.5),
        'w_out': nrm((L, D_MODEL, D_MODEL), d_in),
        'w_up': nrm((L, D_MODEL, 2 * D_FF), d_in),
        'conv_w': nrm((L, CONV_W, 2 * D_FF), CONV_W ** -0.5),
        'conv_b': nrm((L, 2 * D_FF), 0.01),
        'w_down': nrm((L, D_FF, D_MODEL), D_FF ** -0.5),
        'final_g': 1.0 + nrm((D_MODEL,), 0.1),
    }


def reference(x_prompt, x_sample, c_prompt, c_sample, state_s5, state_rwkv_shift, state_rwkv,
              state_hgrn, state_ffn_conv, w_ada, b_ada, g_mix, g_ffn, w_in, s5_lambda_re,
              s5_lambda_im, s5_log_dt, s5_b_re, s5_b_im, s5_c_re, s5_c_im, s5_d, s5_w_glu,
              s5_b_glu, rw_mu, rw_w0, rw_w2, rw_a0, rw_a2, rw_g2, rw_k_k, rw_k_a, rw_r_k,
              rw_ln_w, rw_ln_b, hg_lb, hg_norm, w_lift_a, w_lift_b, w_lift_c, w_out, w_up,
              conv_w, conv_b, w_down, final_g):
    prm = {
        'w_ada': w_ada, 'b_ada': b_ada, 'g_mix': g_mix, 'g_ffn': g_ffn, 'w_in': w_in,
        's5_lambda_re': s5_lambda_re, 's5_lambda_im': s5_lambda_im, 's5_log_dt': s5_log_dt,
        's5_b_re': s5_b_re, 's5_b_im': s5_b_im, 's5_c_re': s5_c_re, 's5_c_im': s5_c_im,
        's5_d': s5_d, 's5_w_glu': s5_w_glu, 's5_b_glu': s5_b_glu,
        'rw_mu': rw_mu, 'rw_w0': rw_w0, 'rw_w2': rw_w2, 'rw_a0': rw_a0, 'rw_a2': rw_a2,
        'rw_g2': rw_g2, 'rw_k_k': rw_k_k, 'rw_k_a': rw_k_a, 'rw_r_k': rw_r_k,
        'rw_ln_w': rw_ln_w, 'rw_ln_b': rw_ln_b, 'hg_norm': hg_norm,
        'w_lift_a': w_lift_a, 'w_lift_b': w_lift_b, 'w_lift_c': w_lift_c, 'w_out': w_out,
        'w_up': w_up, 'conv_w': conv_w, 'conv_b': conv_b, 'w_down': w_down,
    }
    lbp = jax.nn.softmax(hg_lb.astype(F32), axis=0)
    lower = jnp.cumsum(lbp, axis=0) - lbp[0]

    nb = x_prompt.shape[0]
    z_s5 = jnp.zeros((DEPTH, nb) + state_s5.shape[2:], F32)
    z_shift = jnp.zeros((DEPTH, nb) + state_rwkv_shift.shape[2:], F32)
    z_rw = jnp.zeros((DEPTH, nb) + state_rwkv.shape[2:], F32)
    z_hg = jnp.zeros((DEPTH, nb) + state_hgrn.shape[2:], F32)
    z_conv = jnp.zeros((DEPTH, nb) + state_ffn_conv.shape[2:], F32)

    y_prompt, (s5_p, shift_p, rw_p, hg_p, conv_p) = run_trunk(
        x_prompt, c_prompt, z_s5, z_shift, z_rw, z_hg, z_conv, lower, final_g, prm)
    y_sample, (s5_s, shift_s, rw_s, hg_s, conv_s) = run_trunk(
        x_sample, c_sample, state_s5, state_rwkv_shift, state_rwkv, state_hgrn, state_ffn_conv,
        lower, final_g, prm)
    return (y_prompt, y_sample, s5_p, shift_p, rw_p, hg_p, conv_p, s5_s, shift_s, rw_s, hg_s, conv_s)
```

```cpp
#include <hip/hip_runtime.h>
#include <hip/hip_cooperative_groups.h>
#include <cstdio>
#include <cstdint>
namespace cg = cooperative_groups;

#ifndef N_LAUNCH_MODE
#define N_LAUNCH_MODE 1
#endif

#define LAS __attribute__((address_space(3)))
typedef unsigned short bf16_t;
typedef short bf16x8 __attribute__((ext_vector_type(8)));
typedef float f32x4 __attribute__((ext_vector_type(4)));
typedef unsigned u32x4 __attribute__((ext_vector_type(4)));
typedef unsigned u32x2 __attribute__((ext_vector_type(2)));
typedef float f32x2v __attribute__((ext_vector_type(2)));

constexpr int D = 1024, TP = 16384, TS = 512, T = TP + TS, NSEQ = 136;
constexpr int ZC = 2944, GC = 3072, INC = 6016, INP = 6144, FF = 2816, FF2 = 5632, RWC = 1664;
constexpr int NTHREADS = 512, NWAVES = 8;
constexpr int LDS_BYTES = 147456;

constexpr size_t O_YP = 0, O_YS = 16777216, O_S5P = 17301504, O_SHP = 17334272, O_RWP = 17360896, O_HGP = 17885184, O_CVP = 18147328,
                 O_S5S = 18327552, O_SHS = 18851840, O_RWS = 19277824, O_HGS = 27666432, O_CVS = 31860736;

constexpr size_t WS_MOD = 4096;
constexpr size_t WS_WIN = WS_MOD + (size_t)2 * NSEQ * 6144 * 4;
constexpr size_t WS_LA = WS_WIN + (size_t)INP * 1024 * 2;
constexpr size_t WS_LB = WS_LA + (size_t)1024 * 256 * 2;
constexpr size_t WS_LC = WS_LB + (size_t)1024 * 512 * 2;
constexpr size_t WS_WGLU = WS_LC + (size_t)1024 * 256 * 2;
constexpr size_t WS_WOUT3 = WS_WGLU + (size_t)256 * 256 * 2;
constexpr size_t WS_WUP = WS_WOUT3 + (size_t)1024 * 3072 * 2;
constexpr size_t WS_WDN = WS_WUP + (size_t)FF2 * 1024 * 2;
constexpr size_t WS_H = WS_WDN + (size_t)1024 * FF * 2;
constexpr size_t WS_YPRE = WS_H + (size_t)T * 1024 * 2;
constexpr size_t WS_HALO = WS_YPRE + (size_t)T * 256 * 2;
constexpr size_t WS_BIG = WS_HALO + (size_t)66 * 2 * FF2 * 2;
constexpr size_t WS_Z = WS_BIG, WS_G = WS_Z + (size_t)T * ZC * 2, WS_UP = WS_BIG;
constexpr size_t WS_WADA = WS_BIG, WS_AADA = WS_WADA + (size_t)12288 * 1024 * 2;
constexpr size_t WS_BAR = WS_G + (size_t)T * GC * 2;
constexpr size_t WS_END = WS_BAR + 16384;

struct Params { const float* in[46]; float* out; unsigned char* ws; };
typedef const __attribute__((address_space(4))) Params& PRef;

enum { I_XP = 0, I_XS, I_CP, I_CS, I_SS5, I_SSH, I_SRW, I_SHG, I_SCV, I_WADA, I_BADA, I_GMIX, I_GFFN, I_WIN, I_LRE, I_LIM, I_LDT, I_BRE, I_BIM, I_CRE, I_CIM, I_S5D, I_WGLU, I_BGLU,
       I_MU, I_W0, I_W2, I_A0, I_A2, I_G2, I_KK, I_KA, I_RK, I_LNW, I_LNB, I_HLB, I_HNORM, I_LFA, I_LFB, I_LFC, I_WOUT, I_WUP, I_CW, I_CB, I_WDN, I_FG };

__device__ __forceinline__ unsigned short f2bf(float f) { unsigned u = __float_as_uint(f); u += 0x7FFFu + ((u >> 16) & 1u); return (unsigned short)(u >> 16); }
__device__ __forceinline__ float bf2f(unsigned short b) { return __uint_as_float(((unsigned)b) << 16); }
__device__ __forceinline__ float bflo(unsigned w) { return __uint_as_float(w << 16); }
__device__ __forceinline__ float bfhi(unsigned w) { return __uint_as_float(w & 0xFFFF0000u); }
typedef __bf16 bf16x2_t __attribute__((ext_vector_type(2)));
__device__ __forceinline__ unsigned cvt_pk_bf16(float lo, float hi) {
    bf16x2_t v; v.x = (__bf16)lo; v.y = (__bf16)hi; return __builtin_bit_cast(unsigned, v); }
__device__ __forceinline__ float fsigmoid(float x) { return __builtin_amdgcn_rcpf(1.0f + __expf(-x)); }
__device__ __forceinline__ float gelu_tanh(float x) { return x * fsigmoid(1.5957691216f * (x + 0.044715f * x * x * x)); }
#define DPP_ADD(v, CTRL) ((v) + __int_as_float(__builtin_amdgcn_update_dpp(0, __float_as_int(v), (CTRL), 0xF, 0xF, true)))
__device__ __forceinline__ float wave_sum(float v) {
    v = DPP_ADD(v, 0xB1); v = DPP_ADD(v, 0x4E); v = DPP_ADD(v, 0x141); v = DPP_ADD(v, 0x140);
    const float r0 = __int_as_float(__builtin_amdgcn_readlane(__float_as_int(v), 0)), r1 = __int_as_float(__builtin_amdgcn_readlane(__float_as_int(v), 16));
    const float r2 = __int_as_float(__builtin_amdgcn_readlane(__float_as_int(v), 32)), r3 = __int_as_float(__builtin_amdgcn_readlane(__float_as_int(v), 48));
    return (r0 + r1) + (r2 + r3);
}
__device__ __forceinline__ float red8(float v) { v = DPP_ADD(v, 0xB1); v = DPP_ADD(v, 0x4E); v = DPP_ADD(v, 0x141); return v; }
__device__ __forceinline__ int row2seq(int row) { return row < TP ? (row >> 11) : 8 + ((row - TP) >> 2); }
#define LDS_FENCE() asm volatile("s_waitcnt lgkmcnt(0)" ::: "memory")

namespace pg8 {
constexpr int BM = 256, BK = 64, HALF = 128, HTB = HALF * BK * 2, STAGE_BYTES = 8 * HTB, NXCD = 8, WGM = 8;
__host__ __device__ __forceinline__ int lds_byte(int r, int c) { const int st = (r >> 4) * 2 + (c >> 5), rr = r & 15, cc = c & 31, ob = rr * 64 + cc * 2; return st * 1024 + (ob ^ (((ob >> 9) & 1) << 5)); }
__host__ __device__ __forceinline__ void stage_rc(int b, int& R, int& C) { const int st = b / 1024, sb = b % 1024, swz = sb ^ (((sb >> 9) & 1) << 5); R = (st >> 1) * 16 + swz / 64; C = (st & 1) * 32 + (swz % 64) / 2; }
__host__ __device__ __forceinline__ int perm32(int rho) { const int n = rho >> 4, i = rho & 15; return 8 * (i >> 2) + 4 * n + (i & 3); }
struct Unit { int pm, pn; };
struct Gemm { const bf16_t* A; const bf16_t* Bt; int M, N, K, lda; };
struct StaticOrder {
    int nM, nN, nwg, G, c;
    __device__ void init(int M, int N, int G_, int c_) { nM = M / BM; nN = N / BM; nwg = nM * nN; G = G_; c = c_; }
    __device__ bool next(int i, Unit& u) const {
        const long L = (long)i * G + c; if (L >= nwg) return false;
        int wgid = (int)L; { const int q = nwg / NXCD, r = nwg % NXCD, xcd = wgid % NXCD, off = wgid / NXCD; wgid = (xcd < r ? xcd * (q + 1) : r * (q + 1) + (xcd - r) * q) + off; }
        const int nig = WGM * nN, gid = wgid / nig, fm = gid * WGM, gsz = (nM - fm) < WGM ? (nM - fm) : WGM;
        u.pm = fm + ((wgid % nig) % gsz); u.pn = (wgid % nig) / gsz; return true;
    }
};

template <class Epi>
__device__ __forceinline__ void gemm_phase(LAS unsigned char* lds, const Gemm g, const StaticOrder& S, const Epi& E, const int tid) {
    const int wid = __builtin_amdgcn_readfirstlane(tid >> 6), lane = tid & 63, wr = wid >> 2, wc = wid & 3, fr = lane & 15, fq = lane >> 4;
    const int K = g.K, nt = K / BK, lda = g.lda;
    unsigned voffA[2], voffB[2];
#pragma unroll
    for (int i = 0; i < 2; ++i) { int R, C; stage_rc(tid * 16 + i * 8192, R, C); const int Rb = Epi::PERM ? ((R & ~31) + perm32(R & 31)) : R;
        voffA[i] = (unsigned)(R * lda + C) * 2u; voffB[i] = (unsigned)(Rb * K + C) * 2u; }
    const size_t kstep = (size_t)(BK * 2);
    const size_t hstepA = (size_t)HALF * lda * 2, hstepB = (size_t)HALF * K * 2;
    const size_t tstepA = 2 * hstepA, tstepB = 2 * hstepB;
    const unsigned ldsw = (unsigned)wid * 1024u;
    const int aoff = lds_byte(wr * 64 + fr, fq * 8), boff = lds_byte(wc * 32 + fr, fq * 8);
#define PG8_SA(b, h) (((b) * 2 + (h)) * HTB)
#define PG8_SB(b, h) ((4 + (b) * 2 + (h)) * HTB)
#define PG8_STAGE(bufoff, gbase, voff) do { _Pragma("unroll") for (int _i = 0; _i < 2; ++_i) \
        __builtin_amdgcn_global_load_lds((const unsigned*)((const char*)(gbase) + (voff)[_i]), (LAS unsigned*)(lds + (bufoff) + ldsw + _i * 8192), 16, 0, 0); } while (0)
#define PG8_LDA(dst, b, h) do { _Pragma("unroll") for (int m = 0; m < 4; ++m) _Pragma("unroll") for (int k = 0; k < 2; ++k) dst[m][k] = *(const LAS bf16x8*)(lds + PG8_SA(b, h) + aoff + m * 2048 + k * 1024); } while (0)
#define PG8_LDB(dst, b, h) do { _Pragma("unroll") for (int n = 0; n < 2; ++n) _Pragma("unroll") for (int k = 0; k < 2; ++k) dst[n][k] = *(const LAS bf16x8*)(lds + PG8_SB(b, h) + boff + n * 2048 + k * 1024); } while (0)
#define PG8_MMA(ai, bj, At, Bt) do { __builtin_amdgcn_s_setprio(1); _Pragma("unroll") for (int m = 0; m < 4; ++m) _Pragma("unroll") for (int n = 0; n < 2; ++n) _Pragma("unroll") for (int k = 0; k < 2; ++k) \
        acc[ai][bj][m][n] = __builtin_amdgcn_mfma_f32_16x16x32_bf16(Bt[n][k], At[m][k], acc[ai][bj][m][n], 0, 0, 0); __builtin_amdgcn_s_setprio(0); } while (0)
#define PG8_WAIT_V(n) asm volatile("s_waitcnt vmcnt(" #n ")" ::: "memory")
#define PG8_WAIT_L(n) asm volatile("s_waitcnt lgkmcnt(" #n ")" ::: "memory")
#define PG8_BAR __builtin_amdgcn_s_barrier()
#define PG8_SCHED __builtin_amdgcn_sched_barrier(0)
    Unit cur, nxt; int ui = 0;
    if (!S.next(0, cur)) return;
    f32x4 acc[2][2][4][2];
#pragma unroll
    for (int a = 0; a < 2; ++a)
#pragma unroll
        for (int b = 0; b < 2; ++b)
#pragma unroll
            for (int m = 0; m < 4; ++m)
#pragma unroll
                for (int n = 0; n < 2; ++n) acc[a][b][m][n] = (f32x4){0.f, 0.f, 0.f, 0.f};
    bf16x8 At[4][2], B0[2][2], B1[2][2];
    const char* cA = (const char*)g.A + (size_t)cur.pm * tstepA; const char* cB = (const char*)g.Bt + (size_t)cur.pn * tstepB;
    PG8_STAGE(PG8_SB(0, 0), cB, voffB); PG8_STAGE(PG8_SA(0, 0), cA, voffA); PG8_STAGE(PG8_SB(0, 1), cB + hstepB, voffB); PG8_STAGE(PG8_SA(0, 1), cA + hstepA, voffA);
    if (wr == 1) PG8_BAR;
    PG8_WAIT_V(4); PG8_BAR;
    PG8_STAGE(PG8_SB(1, 0), cB + kstep, voffB); PG8_STAGE(PG8_SA(1, 0), cA + kstep, voffA); PG8_STAGE(PG8_SB(1, 1), cB + hstepB + kstep, voffB);
    PG8_WAIT_V(6); PG8_BAR;
    for (;;) {
        const bool has_next = S.next(ui + 1, nxt);
        const char* nA = has_next ? (const char*)g.A + (size_t)nxt.pm * tstepA : cA; const char* nB = has_next ? (const char*)g.Bt + (size_t)nxt.pn * tstepB : cB;
        for (int t = 0; t < nt; t += 2) {
            const bool last = (t == nt - 2);
            const char* a1 = cA + (size_t)(t + 1) * kstep;
            const char* a2 = last ? nA : cA + (size_t)(t + 2) * kstep; const char* b2 = last ? nB : cB + (size_t)(t + 2) * kstep;
            const char* a3 = a2 + kstep; const char* b3 = b2 + kstep;
            PG8_LDB(B0, 0, 0); PG8_SCHED; PG8_LDA(At, 0, 0); PG8_STAGE(PG8_SA(1, 1), a1 + hstepA, voffA);
            PG8_WAIT_L(8); PG8_BAR; PG8_WAIT_L(0); PG8_MMA(0, 0, At, B0); PG8_BAR; PG8_SCHED;
            PG8_LDB(B1, 0, 1); PG8_STAGE(PG8_SB(0, 0), b2, voffB);
            PG8_BAR; PG8_WAIT_L(0); PG8_MMA(0, 1, At, B1); PG8_BAR;
            PG8_LDA(At, 0, 1); PG8_STAGE(PG8_SA(0, 0), a2, voffA);
            PG8_BAR; PG8_WAIT_L(0); PG8_MMA(1, 0, At, B0); PG8_BAR; PG8_SCHED;
            PG8_STAGE(PG8_SB(0, 1), b2 + hstepB, voffB);
            PG8_WAIT_V(6); PG8_BAR; PG8_MMA(1, 1, At, B1); PG8_BAR;
            PG8_LDB(B0, 1, 0); PG8_SCHED; PG8_LDA(At, 1, 0); PG8_STAGE(PG8_SA(0, 1), a2 + hstepA, voffA);
            PG8_WAIT_L(8); PG8_BAR; PG8_WAIT_L(0); PG8_MMA(0, 0, At, B0); PG8_BAR; PG8_SCHED;
            PG8_LDB(B1, 1, 1); PG8_STAGE(PG8_SB(1, 0), b3, voffB);
            PG8_BAR; PG8_WAIT_L(0); PG8_MMA(0, 1, At, B1); PG8_BAR;
            PG8_LDA(At, 1, 1); PG8_STAGE(PG8_SA(1, 0), a3, voffA);
            PG8_BAR; PG8_WAIT_L(0); PG8_MMA(1, 0, At, B0); PG8_BAR; PG8_SCHED;
            PG8_STAGE(PG8_SB(1, 1), b3 + hstepB, voffB);
            PG8_WAIT_V(6); PG8_BAR; PG8_MMA(1, 1, At, B1); PG8_BAR;
        }
        { int fr_ = fr, fq_ = fq; asm volatile("" : "+v"(fr_), "+v"(fq_));
          E(acc, cur, wr, wc, fr_, fq_); }
        if (!has_next) break;
#pragma unroll
        for (int a = 0; a < 2; ++a)
#pragma unroll
            for (int b = 0; b < 2; ++b)
#pragma unroll
                for (int m = 0; m < 4; ++m)
#pragma unroll
                    for (int n = 0; n < 2; ++n) acc[a][b][m][n] = (f32x4){0.f, 0.f, 0.f, 0.f};
        cur = nxt; cA = nA; cB = nB; ++ui;
    }
    PG8_WAIT_V(0);
    if (wr == 0) PG8_BAR;
    PG8_BAR;
#undef PG8_SA
#undef PG8_SB
#undef PG8_STAGE
#undef PG8_LDA
#undef PG8_LDB
#undef PG8_MMA
#undef PG8_WAIT_V
#undef PG8_WAIT_L
#undef PG8_BAR
#undef PG8_SCHED
}
}
using pg8::Unit;
typedef f32x4 AccT[2][2][4][2];

#define EPI_LOOP_PERM(...) \
    _Pragma("unroll") for (int ai = 0; ai < 2; ++ai) _Pragma("unroll") for (int m = 0; m < 4; ++m) { const int row = u.pm * 256 + ai * 128 + wr * 64 + m * 16 + fr; \
        _Pragma("unroll") for (int bj = 0; bj < 2; ++bj) { const int col0 = u.pn * 256 + bj * 128 + wc * 32 + 8 * fq; const f32x4 v0 = acc[ai][bj][m][0], v1 = acc[ai][bj][m][1]; __VA_ARGS__ } }
#define EPI_LOOP_NOPERM(...) \
    _Pragma("unroll") for (int ai = 0; ai < 2; ++ai) _Pragma("unroll") for (int m = 0; m < 4; ++m) { const int row = u.pm * 256 + ai * 128 + wr * 64 + m * 16 + fr; \
        _Pragma("unroll") for (int bj = 0; bj < 2; ++bj) _Pragma("unroll") for (int n = 0; n < 2; ++n) { const int col0 = u.pn * 256 + bj * 128 + wc * 32 + 16 * n + 4 * fq; const f32x4 v = acc[ai][bj][m][n]; __VA_ARGS__ } }

__device__ __forceinline__ u32x4 pack8(f32x4 a, f32x4 b) { u32x4 w; w.x = cvt_pk_bf16(a[0], a[1]); w.y = cvt_pk_bf16(a[2], a[3]); w.z = cvt_pk_bf16(b[0], b[1]); w.w = cvt_pk_bf16(b[2], b[3]); return w; }

struct EpiAda {
    static constexpr bool PERM = false;
    float* mod; const float* bada;
    __device__ __forceinline__ void operator()(const AccT& acc, const Unit& u, int wr, int wc, int fr, int fq) const {
        EPI_LOOP_NOPERM( if (row < NSEQ) { const int layer = col0 / 6144, c = col0 - layer * 6144; const f32x4 b = *(const f32x4*)(bada + (size_t)layer * 6144 + c);
            *(f32x4*)(mod + ((size_t)layer * NSEQ + row) * 6144 + c) = v + b; } )
    }
};
struct EpiZ {
    static constexpr bool PERM = true;
    bf16_t* zb; bf16_t* gb; float* out; int layer;
    __device__ __forceinline__ void operator()(const AccT& acc, const Unit& u, int wr, int wc, int fr, int fq) const {
        EPI_LOOP_PERM(
            if (col0 < ZC) { *(u32x4*)(zb + (size_t)row * ZC + col0) = pack8(v0, v1);
                if (col0 >= 256 && col0 < 1920) { const bool last = row < TP ? ((row & 2047) == 2047) : ((row & 3) == 3);
                    if (last) { float* o = row < TP ? out + O_SHP + (size_t)(layer * 8 + (row >> 11)) * RWC : out + O_SHS + (size_t)(layer * 128 + ((row - TP) >> 2)) * RWC;
                        *(f32x4*)(o + col0 - 256) = v0; *(f32x4*)(o + col0 - 252) = v1; } } }
            else if (col0 < INC) { f32x4 s0, s1;
                _Pragma("unroll") for (int j = 0; j < 4; ++j) { s0[j] = fsigmoid(v0[j]); s1[j] = fsigmoid(v1[j]); }
                *(u32x4*)(gb + (size_t)row * GC + (col0 - ZC)) = pack8(s0, s1); } )
    }
};
struct EpiGlu {
    static constexpr bool PERM = true;
    const bf16_t* ypre; bf16_t* yabc; const float* bglu;
    __device__ __forceinline__ void operator()(const AccT& acc, const Unit& u, int wr, int wc, int fr, int fq) const {
#pragma unroll
        for (int bj = 0; bj < 2; ++bj) { const int col0 = u.pn * 256 + bj * 128 + wc * 32 + 8 * fq;
            const f32x4 b0 = *(const f32x4*)(bglu + col0), b1 = *(const f32x4*)(bglu + col0 + 4);
#pragma unroll
            for (int ai = 0; ai < 2; ++ai)
#pragma unroll
                for (int m = 0; m < 4; ++m) { const int row = u.pm * 256 + ai * 128 + wr * 64 + m * 16 + fr;
                    const f32x4 v0 = acc[ai][bj][m][0] + b0, v1 = acc[ai][bj][m][1] + b1;
                    const u32x4 y = *(const u32x4*)(ypre + (size_t)row * 256 + col0);
                    f32x4 o0, o1;
                    o0[0] = bflo(y.x) * fsigmoid(v0[0]); o0[1] = bfhi(y.x) * fsigmoid(v0[1]); o0[2] = bflo(y.y) * fsigmoid(v0[2]); o0[3] = bfhi(y.y) * fsigmoid(v0[3]);
                    o1[0] = bflo(y.z) * fsigmoid(v1[0]); o1[1] = bfhi(y.z) * fsigmoid(v1[1]); o1[2] = bflo(y.w) * fsigmoid(v1[2]); o1[3] = bfhi(y.w) * fsigmoid(v1[3]);
                    *(u32x4*)(yabc + (size_t)row * 1024 + col0) = pack8(o0, o1);
                    asm volatile("" ::: "memory"); } }
    }
};
struct EpiLift {
    static constexpr bool PERM = true;
    bf16_t* gb; int j;
    __device__ __forceinline__ void operator()(const AccT& acc, const Unit& u, int wr, int wc, int fr, int fq) const {
        EPI_LOOP_PERM( bf16_t* pg = gb + (size_t)row * GC + j * 1024 + col0; bf16_t* pd = gb + (size_t)row * GC + col0; const u32x4 g = *(const u32x4*)pg; f32x4 o0, o1;
            o0[0] = bflo(g.x) * v0[0]; o0[1] = bfhi(g.x) * v0[1]; o0[2] = bflo(g.y) * v0[2]; o0[3] = bfhi(g.y) * v0[3];
            o1[0] = bflo(g.z) * v1[0]; o1[1] = bfhi(g.z) * v1[1]; o1[2] = bflo(g.w) * v1[2]; o1[3] = bfhi(g.w) * v1[3];
            if (j > 0) { const u32x4 d = *(const u32x4*)pd;
                o0[0] += bflo(d.x); o0[1] += bfhi(d.x); o0[2] += bflo(d.y); o0[3] += bfhi(d.y); o1[0] += bflo(d.z); o1[1] += bfhi(d.z); o1[2] += bflo(d.w); o1[3] += bfhi(d.w); }
            *(u32x4*)pd = pack8(o0, o1); )
    }
};
struct EpiRes {
    static constexpr bool PERM = false;
    float* hres; const float* gate;
    __device__ __forceinline__ void operator()(const AccT& acc, const Unit& u, int wr, int wc, int fr, int fq) const {
        EPI_LOOP_NOPERM( const f32x4 g = *(const f32x4*)(gate + (size_t)row2seq(row) * 6144 + col0); float* p = hres + (size_t)row * 1024 + col0; *(f32x4*)p = *(const f32x4*)p + g * v; )
    }
};
struct EpiUp {
    static constexpr bool PERM = true;
    bf16_t* up; bf16_t* halo; float* out; int layer;
    __device__ __forceinline__ void operator()(const AccT& acc, const Unit& u, int wr, int wc, int fr, int fq) const {
        EPI_LOOP_PERM( const u32x4 w = pack8(v0, v1); *(u32x4*)(up + (size_t)row * FF2 + col0) = w;
            const int r = row & 255; if (r >= 254) *(u32x4*)(halo + ((size_t)(row >> 8) * 2 + (r - 254)) * FF2 + col0) = w;
            const int tl = row < TP ? (row & 2047) - 2046 : (row & 3) - 2;
            if (tl >= 0) { float* o = row < TP ? out + O_CVP + ((size_t)(layer * 8 + (row >> 11)) * 2 + tl) * FF2 : out + O_CVS + ((size_t)(layer * 128 + ((row - TP) >> 2)) * 2 + tl) * FF2;
                *(f32x4*)(o + col0) = v0; *(f32x4*)(o + col0 + 4) = v1; } )
    }
};

struct Ctx { int tid, lane, wave, b, G; unsigned char* lds; };

template <class Epi>
__device__ __forceinline__ void run_gemm(const Ctx& c, const bf16_t* A, int lda, const bf16_t* Bt, int M, int N, int K, const Epi& E) {
    pg8::Gemm g; g.A = A; g.Bt = Bt; g.M = M; g.N = N; g.K = K; g.lda = lda;
    pg8::StaticOrder S; S.init(M, N, c.G, c.b);
    pg8::gemm_phase<Epi>((LAS unsigned char*)c.lds, g, S, E, c.tid);
}

__device__ __forceinline__ void transpose_item(const float* W, int N, bf16_t* WT, int ldk, int koff, int nrep, float* scr, int item, int lane) {
    const int nblk = N / 32, kb = item / nblk, nb = item % nblk, k0 = 64 * kb, n0 = 32 * nb;
#pragma unroll
    for (int i = 0; i < 8; ++i) { const int kk = 8 * i + (lane >> 3), cq = 4 * (lane & 7);
        const f32x4 w = *(const f32x4*)(W + (size_t)(k0 + kk) * N + n0 + cq);
        scr[kk * 33 + cq] = w[0]; scr[kk * 33 + cq + 1] = w[1]; scr[kk * 33 + cq + 2] = w[2]; scr[kk * 33 + cq + 3] = w[3]; }
    LDS_FENCE();
    const int cc = lane & 7;
#pragma unroll
    for (int j = 0; j < 4; ++j) { const int n = (lane >> 3) + 8 * j; const float* s = scr + (8 * cc) * 33 + n;
        u32x4 o; o.x = cvt_pk_bf16(s[0 * 33], s[1 * 33]); o.y = cvt_pk_bf16(s[2 * 33], s[3 * 33]); o.z = cvt_pk_bf16(s[4 * 33], s[5 * 33]); o.w = cvt_pk_bf16(s[6 * 33], s[7 * 33]);
        for (int r = 0; r < nrep; ++r) *(u32x4*)(WT + (size_t)(n0 + n) * ldk + koff + r * 1024 + k0 + 8 * cc) = o; }
    LDS_FENCE();
}
struct TJob { const float* W; int K, N; bf16_t* WT; int ldk, nrep; };
__device__ __forceinline__ void convert_jobs(const Ctx& c, const TJob* jobs, int njobs) {
    float* scr = (float*)(c.lds) + c.wave * (64 * 33);
    const int gw = c.b * NWAVES + c.wave, NGW = c.G * NWAVES;
    int base = 0;
    for (int j = 0; j < njobs; ++j) {
        const int items = (jobs[j].K / 64) * (jobs[j].N / 32);
        int first = (gw - (base % NGW) + NGW) % NGW;
        for (int it = first; it < items; it += NGW) transpose_item(jobs[j].W, jobs[j].N, jobs[j].WT, jobs[j].ldk, 0, jobs[j].nrep, scr, it, c.lane);
        base += items;
    }
}
__device__ __forceinline__ void convert_layer_weights(PRef P, const Ctx& c, int layer, int which = 0) {
    unsigned char* ws = P.ws;
    TJob jobs[8];
    jobs[0] = TJob{P.in[I_WIN] + (size_t)layer * 1024 * INC, 1024, INC, (bf16_t*)(ws + WS_WIN), 1024, 1};
    jobs[1] = TJob{P.in[I_WUP] + (size_t)layer * 1024 * FF2, 1024, FF2, (bf16_t*)(ws + WS_WUP), 1024, 1};
    jobs[2] = TJob{P.in[I_WDN] + (size_t)layer * FF * 1024, FF, 1024, (bf16_t*)(ws + WS_WDN), FF, 1};
    jobs[3] = TJob{P.in[I_WOUT] + (size_t)layer * 1024 * 1024, 1024, 1024, (bf16_t*)(ws + WS_WOUT3), 1024, 1};
    jobs[4] = TJob{P.in[I_LFB] + (size_t)layer * 512 * 1024, 512, 1024, (bf16_t*)(ws + WS_LB), 512, 1};
    jobs[5] = TJob{P.in[I_LFA] + (size_t)layer * 256 * 1024, 256, 1024, (bf16_t*)(ws + WS_LA), 256, 1};
    jobs[6] = TJob{P.in[I_LFC] + (size_t)layer * 256 * 1024, 256, 1024, (bf16_t*)(ws + WS_LC), 256, 1};
    jobs[7] = TJob{P.in[I_WGLU] + (size_t)layer * 256 * 256, 256, 256, (bf16_t*)(ws + WS_WGLU), 256, 1};
#pragma unroll
    for (int j = 0; j < 8; ++j) { if ((which == 1 && j != 0) || (which == 2 && j == 0)) continue; TJob one = jobs[j]; convert_jobs(c, &one, 1); }
}

__device__ __forceinline__ void phase_start(PRef P, const Ctx& c) {
    unsigned char* ws = P.ws;
    for (int l = 0; l < 2; ++l) { TJob one{P.in[I_WADA] + (size_t)l * 1024 * 6144, 1024, 6144, (bf16_t*)(ws + WS_WADA) + (size_t)l * 6144 * 1024, 1024, 1}; convert_jobs(c, &one, 1); }
    convert_layer_weights(P, c, 0, c.G == 256 ? 1 : 0);
    bf16_t* aada = (bf16_t*)(ws + WS_AADA);
    for (int i = c.b * NTHREADS + c.tid; i < 256 * 1024; i += c.G * NTHREADS) {
        const int r = i >> 10, k = i & 1023; float v = 0.f;
        if (r < NSEQ) { const float x = r < 8 ? P.in[I_CP][r * 1024 + k] : P.in[I_CS][(r - 8) * 1024 + k]; v = x * fsigmoid(x); }
        aada[i] = f2bf(v);
    }
}

__device__ __forceinline__ void phase_norm(PRef P, const Ctx& c, int layer, int which, bool first) {
    const float* mod = (const float*)(P.ws + WS_MOD) + (size_t)layer * NSEQ * 6144;
    const float* gw_ = P.in[which ? I_GFFN : I_GMIX] + layer * 1024;
    bf16_t* H = (bf16_t*)(P.ws + WS_H);
    const int gw = c.b * NWAVES + c.wave, NGW = c.G * NWAVES;
    for (int row = gw; row < T; row += NGW) {
        const float* src = first ? (row < TP ? P.in[I_XP] + (size_t)row * 1024 : P.in[I_XS] + (size_t)(row - TP) * 1024) : P.out + (size_t)row * 1024;
        const float* m = mod + (size_t)row2seq(row) * 6144 + (which ? 3 : 0) * 1024;
        f32x4 v[4]; float ss = 0.f;
#pragma unroll
        for (int j = 0; j < 4; ++j) { v[j] = *(const f32x4*)(src + 256 * j + 4 * c.lane); ss += (v[j][0] * v[j][0] + v[j][1] * v[j][1]) + (v[j][2] * v[j][2] + v[j][3] * v[j][3]); }
        const float rstd = rsqrtf(wave_sum(ss) * (1.f / 1024.f) + 1e-6f);
#pragma unroll
        for (int j = 0; j < 4; ++j) { const int col = 256 * j + 4 * c.lane;
            const f32x4 g = *(const f32x4*)(gw_ + col), sh = *(const f32x4*)(m + col), sc = *(const f32x4*)(m + 1024 + col);
            if (first) *(f32x4*)(P.out + (size_t)row * 1024 + col) = v[j];
            f32x4 h;
#pragma unroll
            for (int e = 0; e < 4; ++e) h[e] = v[j][e] * rstd * g[e] * (1.f + sc[e]) + sh[e];
            u32x2 w; w.x = cvt_pk_bf16(h[0], h[1]); w.y = cvt_pk_bf16(h[2], h[3]);
            *(u32x2*)(H + (size_t)row * 1024 + col) = w; }
    }
}
__device__ __forceinline__ void phase_final_norm(PRef P, const Ctx& c) {
    const float* fg = P.in[I_FG];
    const int gw = c.b * NWAVES + c.wave, NGW = c.G * NWAVES;
    for (int row = gw; row < T; row += NGW) {
        float* src = P.out + (size_t)row * 1024;
        f32x4 v[4]; float ss = 0.f;
#pragma unroll
        for (int j = 0; j < 4; ++j) { v[j] = *(const f32x4*)(src + 256 * j + 4 * c.lane); ss += (v[j][0] * v[j][0] + v[j][1] * v[j][1]) + (v[j][2] * v[j][2] + v[j][3] * v[j][3]); }
        const float rstd = rsqrtf(wave_sum(ss) * (1.f / 1024.f) + 1e-6f);
#pragma unroll
        for (int j = 0; j < 4; ++j) { const int col = 256 * j + 4 * c.lane; const f32x4 g = *(const f32x4*)(fg + col); *(f32x4*)(src + col) = v[j] * rstd * g; }
    }
}

struct SeqInfo { int n, L, row0; bool prompt; };
__device__ __forceinline__ SeqInfo seq_info(int s) { SeqInfo q; q.prompt = s < 8; q.n = q.prompt ? s : s - 8; q.L = q.prompt ? 2048 : 4; q.row0 = q.prompt ? s * 2048 : TP + (s - 8) * 4; return q; }

__device__ __forceinline__ void rwkv_prefetch(const bf16_t* zb, const SeqInfo& q, int h, int t0, int tid, u32x4 (&pre)[3]) {
    const int len = (q.L - t0) < 32 ? (q.L - t0) : 32;
#pragma unroll
    for (int it = 0; it < 3; ++it) { const int idx = tid + it * NTHREADS; pre[it] = (u32x4){0u, 0u, 0u, 0u};
        if (idx < 33 * 40 && t0 < q.L) { const int rr = idx / 40, vec = idx - rr * 40; const int pc = vec < 24 ? (vec >> 3) * 512 + h * 64 + (vec & 7) * 8 : 1536 + (vec - 24) * 8; const int tg = t0 - 1 + rr;
            if (tg >= 0 && rr <= len) pre[it] = *(const u32x4*)(zb + ((size_t)q.row0 + tg) * ZC + 256 + pc); } }
}
__device__ __forceinline__ void rwkv_unit(PRef P, const Ctx& c, int layer, int s, int h) {
    const SeqInfo q = seq_info(s);
    const bf16_t* zb = (const bf16_t*)(P.ws + WS_Z);
    bf16_t* yabc = (bf16_t*)(P.ws + WS_H);
    float* sm = (float*)c.lds;
    float* XR = sm; float* XK = sm + 2048; float* XV = sm + 4096; float* DEC = sm + 6144; float* AIC = sm + 8192; float* GG = sm + 10240; float* KKn = sm + 12288; float* YO = sm + 14336;
    float* BON = sm + 16384;
    bf16_t* LW = (bf16_t*)(sm + 16448);
    bf16_t* LA = LW + 1024;
    bf16_t* LG = LA + 1024;
    float* RAW = sm + 18496;
    float* MU = sm + 29056;
    const int tid = c.tid, lane = c.lane, wave = c.wave;
    const float* mu = P.in[I_MU] + layer * RWC;
    const float* shiftst = q.prompt ? nullptr : P.in[I_SSH] + ((size_t)layer * 128 + q.n) * RWC;
    const int mt = wave >> 2, ntile = wave & 3, quad = lane >> 4, l15 = lane & 15;
    const int cB = h * 64 + ntile * 16 + l15;
    bf16x8 bW, bA, bG0, bG1;
    {
        const float* w2 = P.in[I_W2] + (size_t)layer * 32 * 512; const float* a2 = P.in[I_A2] + (size_t)layer * 32 * 512; const float* g2 = P.in[I_G2] + (size_t)layer * 64 * 512;
#pragma unroll
        for (int j = 0; j < 8; ++j) { bW[j] = (short)f2bf(w2[(quad * 8 + j) * 512 + cB]); bA[j] = (short)f2bf(a2[(quad * 8 + j) * 512 + cB]);
            bG0[j] = (short)f2bf(g2[(quad * 8 + j) * 512 + cB]); bG1[j] = (short)f2bf(g2[(32 + quad * 8 + j) * 512 + cB]); }
    }
    const float w0c = P.in[I_W0][layer * 512 + cB], a0c = P.in[I_A0][layer * 512 + cB];
    const int cl = h * 64 + lane;
    const float kkc = P.in[I_KK][layer * 512 + cl], kac = P.in[I_KA][layer * 512 + cl], rkc = P.in[I_RK][layer * 512 + cl], lnw = P.in[I_LNW][layer * 512 + cl], lnb = P.in[I_LNB][layer * 512 + cl];
    const int v = tid >> 3, sub = tid & 7;
    float st[8];
    if (q.prompt) {
#pragma unroll
        for (int j = 0; j < 8; ++j) st[j] = 0.f;
    } else {
        const float* sp = P.in[I_SRW] + (((size_t)layer * 128 + q.n) * 8 + h) * 4096 + v * 64 + sub * 8;
        const f32x4 a = *(const f32x4*)sp, b = *(const f32x4*)(sp + 4);
        st[0] = a[0]; st[1] = a[1]; st[2] = a[2]; st[3] = a[3]; st[4] = b[0]; st[5] = b[1]; st[6] = b[2]; st[7] = b[3];
    }
    u32x4 pre[3]; rwkv_prefetch(zb, q, h, 0, tid, pre);
    if (tid < 320) { const int pcm = tid < 192 ? (tid >> 6) * 512 + h * 64 + (tid & 63) : 1536 + (tid - 192); MU[tid] = mu[pcm]; }
    for (int t0 = 0; t0 < q.L; t0 += 32) {
        const int len = (q.L - t0) < 32 ? (q.L - t0) : 32;
#pragma unroll
        for (int it = 0; it < 3; ++it) { const int idx = tid + it * NTHREADS;
            if (idx < 33 * 40) {
                const int rr = idx / 40, vec = idx - rr * 40;
                const int pc = vec < 24 ? (vec >> 3) * 512 + h * 64 + (vec & 7) * 8 : 1536 + (vec - 24) * 8;
                const int tg = t0 - 1 + rr;
                f32x4 x0 = {0.f, 0.f, 0.f, 0.f}, x1 = x0;
                if (tg < 0) { if (!q.prompt) { x0 = *(const f32x4*)(shiftst + pc); x1 = *(const f32x4*)(shiftst + pc + 4); } }
                else if (rr <= len) { const u32x4 w = pre[it];
                    x0 = (f32x4){bflo(w.x), bfhi(w.x), bflo(w.y), bfhi(w.y)}; x1 = (f32x4){bflo(w.z), bfhi(w.z), bflo(w.w), bfhi(w.w)}; }
                *(f32x4*)(RAW + rr * 320 + vec * 8) = x0; *(f32x4*)(RAW + rr * 320 + vec * 8 + 4) = x1; } }
        __syncthreads();
        rwkv_prefetch(zb, q, h, t0 + 32, tid, pre);
        for (int idx = tid; idx < 32 * 48; idx += NTHREADS) {
            const int t = idx / 48, cc = (idx - t * 48) * 4;
            f32x4 xm = {0.f, 0.f, 0.f, 0.f};
            if (t < len) { const f32x4 p = *(const f32x4*)(RAW + (t + 1) * 320 + cc), pp = *(const f32x4*)(RAW + t * 320 + cc), m = *(const f32x4*)(MU + cc); xm = p + (pp - p) * m; }
            float* dst = cc < 64 ? XR + t * 64 + cc : cc < 128 ? XK + t * 64 + cc - 64 : XV + t * 64 + cc - 128;
            *(f32x4*)dst = xm;
        }
        for (int idx = tid; idx < 32 * 128; idx += NTHREADS) {
            const int t = idx >> 7, j = idx & 127, cc = 192 + j;
            float x = 0.f;
            if (t < len) { const float p = RAW[(t + 1) * 320 + cc], pp = RAW[t * 320 + cc]; x = p + (pp - p) * MU[cc]; }
            const float sg = fsigmoid(j < 32 ? 2.f * x : x);
            const float val = j < 32 ? 2.f * sg - 1.f : (j < 64 ? x : sg);
            bf16_t* dst = j < 32 ? LW + t * 32 + j : (j < 64 ? LA + t * 32 + j - 32 : LG + t * 64 + j - 64);
            *dst = f2bf(val);
        }
        __syncthreads();
        {
            const bf16x8 aW = *(const bf16x8*)(LW + (mt * 16 + l15) * 32 + quad * 8), aA = *(const bf16x8*)(LA + (mt * 16 + l15) * 32 + quad * 8);
            const bf16x8 aG0 = *(const bf16x8*)(LG + (mt * 16 + l15) * 64 + quad * 8), aG1 = *(const bf16x8*)(LG + (mt * 16 + l15) * 64 + 32 + quad * 8);
            const f32x4 z4 = {0.f, 0.f, 0.f, 0.f};
            f32x4 cw = __builtin_amdgcn_mfma_f32_16x16x32_bf16(aW, bW, z4, 0, 0, 0);
            f32x4 ca = __builtin_amdgcn_mfma_f32_16x16x32_bf16(aA, bA, z4, 0, 0, 0);
            f32x4 cg_ = __builtin_amdgcn_mfma_f32_16x16x32_bf16(aG0, bG0, z4, 0, 0, 0);
            cg_ = __builtin_amdgcn_mfma_f32_16x16x32_bf16(aG1, bG1, cg_, 0, 0, 0);
#pragma unroll
            for (int j = 0; j < 4; ++j) { const int t = mt * 16 + quad * 4 + j, cc = ntile * 16 + l15;
                const float wv = w0c + cw[j]; const float nx = -wv; const float sp = (nx > 0.f ? nx : 0.f) + __logf(1.f + __expf(-fabsf(nx)));
                DEC[t * 64 + cc] = __expf(-__expf(-sp - 0.5f));
                AIC[t * 64 + cc] = fsigmoid(a0c + ca[j]);
                GG[t * 64 + cc] = cg_[j]; }
        }
        __syncthreads();
#pragma unroll
        for (int i = 0; i < 4; ++i) { const int t = wave + 8 * i; const int o = t * 64 + lane;
            const float k = XK[o], a = AIC[o], r = XR[o];
            const float kkv = k * kkc; const float ssq = wave_sum(kkv * kkv); const float kk = kkv * rsqrtf(fmaxf(ssq, 1e-24f));
            const float kp = k * (1.f + (a - 1.f) * kac);
            const float bon = wave_sum(r * kp * rkc);
            XK[o] = kp; KKn[o] = kk; AIC[o] = kk * a; if (lane == 0) BON[t] = bon; }
        __syncthreads();
        {
            f32x2v s2[4] = {{st[0], st[1]}, {st[2], st[3]}, {st[4], st[5]}, {st[6], st[7]}};
            for (int t = 0; t < len; ++t) {
                const int o = t * 64 + sub * 8;
                const f32x4 r0 = *(const f32x4*)(XR + o), r1 = *(const f32x4*)(XR + o + 4), w0 = *(const f32x4*)(DEC + o), w1 = *(const f32x4*)(DEC + o + 4), k0 = *(const f32x4*)(XK + o), k1 = *(const f32x4*)(XK + o + 4);
                const f32x4 n0 = *(const f32x4*)(KKn + o), n1 = *(const f32x4*)(KKn + o + 4), b0 = *(const f32x4*)(AIC + o), b1 = *(const f32x4*)(AIC + o + 4);
                const float vv = XV[t * 64 + v];
                f32x2v acc = s2[0] * n0.xy; acc = s2[1] * n0.zw + acc; acc = s2[2] * n1.xy + acc; acc = s2[3] * n1.zw + acc;
                const float sa = -red8(acc.x + acc.y);
                const f32x2v sa2 = {sa, sa}, vv2 = {vv, vv};
                s2[0] = s2[0] * w0.xy + (sa2 * b0.xy + vv2 * k0.xy); s2[1] = s2[1] * w0.zw + (sa2 * b0.zw + vv2 * k0.zw);
                s2[2] = s2[2] * w1.xy + (sa2 * b1.xy + vv2 * k1.xy); s2[3] = s2[3] * w1.zw + (sa2 * b1.zw + vv2 * k1.zw);
                f32x2v ya = s2[0] * r0.xy; ya = s2[1] * r0.zw + ya; ya = s2[2] * r1.xy + ya; ya = s2[3] * r1.zw + ya;
                const float y = red8(ya.x + ya.y);
                if (sub == 0) YO[t * 64 + v] = y;
            }
            st[0] = s2[0].x; st[1] = s2[0].y; st[2] = s2[1].x; st[3] = s2[1].y; st[4] = s2[2].x; st[5] = s2[2].y; st[6] = s2[3].x; st[7] = s2[3].y;
        }
        __syncthreads();
#pragma unroll
        for (int i = 0; i < 4; ++i) { const int t = wave + 8 * i; if (t < len) { const int o = t * 64 + lane;
            const float y = YO[o]; const float mean = wave_sum(y) * (1.f / 64.f); const float d = y - mean; const float var = wave_sum(d * d) * (1.f / 64.f);
            const float yn = d * rsqrtf(var + 64e-5f);
            const float res = (yn * lnw + lnb + BON[t] * XV[o]) * GG[o];
            yabc[((size_t)q.row0 + t0 + t) * 1024 + 256 + h * 64 + lane] = f2bf(res); } }
        __syncthreads();
    }
    float* so = q.prompt ? P.out + O_RWP + (((size_t)layer * 8 + q.n) * 8 + h) * 4096 : P.out + O_RWS + (((size_t)layer * 128 + q.n) * 8 + h) * 4096;
    *(f32x4*)(so + v * 64 + sub * 8) = (f32x4){st[0], st[1], st[2], st[3]}; *(f32x4*)(so + v * 64 + sub * 8 + 4) = (f32x4){st[4], st[5], st[6], st[7]};
}

__device__ __forceinline__ void hgrn_unit(PRef P, const Ctx& c, int layer, int s, int h) {
    const SeqInfo q = seq_info(s);
    const bf16_t* zb = (const bf16_t*)(P.ws + WS_Z);
    bf16_t* yabc = (bf16_t*)(P.ws + WS_H);
    float* sm = (float*)c.lds;
    float* FQ = sm; float* FFg = sm + 2048; float* FK = sm + 4096; float* FI = sm + 6144; float* FO = sm + 8192; float* OO = sm + 10240;
    const int tid = c.tid, lane = c.lane, wave = c.wave;
    const int vc = tid >> 3, sub = tid & 7;
    float st[8];
    if (q.prompt) {
#pragma unroll
        for (int j = 0; j < 8; ++j) st[j] = 0.f;
    } else {
        const float* sp = P.in[I_SHG] + (((size_t)layer * 128 + q.n) * 4 + h) * 4096;
#pragma unroll
        for (int j = 0; j < 8; ++j) st[j] = sp[(sub * 8 + j) * 64 + vc];
    }
    const float hn = P.in[I_HNORM][layer * 256 + h * 64 + lane];
    for (int t0 = 0; t0 < q.L; t0 += 32) {
        const int len = (q.L - t0) < 32 ? (q.L - t0) : 32;
        for (int idx = tid; idx < 1024; idx += NTHREADS) {
            const int t = idx >> 5, arr = (idx >> 3) & 3, vec = idx & 7; const int c0 = vec * 8;
            float xv[8];
            if (t < len) { const u32x4 w = *(const u32x4*)(zb + ((size_t)q.row0 + t0 + t) * ZC + 1920 + arr * 256 + h * 64 + c0);
                xv[0] = bflo(w.x); xv[1] = bfhi(w.x); xv[2] = bflo(w.y); xv[3] = bfhi(w.y); xv[4] = bflo(w.z); xv[5] = bfhi(w.z); xv[6] = bflo(w.w); xv[7] = bfhi(w.w); }
            else {
#pragma unroll
                for (int j = 0; j < 8; ++j) xv[j] = 0.f; }
            const int o = t * 64 + c0;
            if (arr == 0) {
#pragma unroll
                for (int j = 0; j < 8; ++j) FQ[o + j] = xv[j] * fsigmoid(xv[j]); }
            else if (arr == 1) {
#pragma unroll
                for (int j = 0; j < 8; ++j) { float lower = 0.f;
                    if (layer == 1) { const float l0 = P.in[I_HLB][h * 64 + c0 + j], l1 = P.in[I_HLB][256 + h * 64 + c0 + j]; lower = fsigmoid(l1 - l0); }
                    const float fg = lower + (1.f - lower) * fsigmoid(xv[j]);
                    FFg[o + j] = fmaxf(fg, 1e-30f); FK[o + j] = 1.f - fg; } }
            else if (arr == 2) {
#pragma unroll
                for (int j = 0; j < 8; ++j) FI[o + j] = xv[j]; }
            else {
#pragma unroll
                for (int j = 0; j < 8; ++j) FO[o + j] = fsigmoid(xv[j]); }
        }
        __syncthreads();
        {
            f32x2v s2[4] = {{st[0], st[1]}, {st[2], st[3]}, {st[4], st[5]}, {st[6], st[7]}};
            for (int t = 0; t < len; ++t) {
                const int o8 = t * 64 + sub * 8;
                const f32x4 q0 = *(const f32x4*)(FQ + o8), q1 = *(const f32x4*)(FQ + o8 + 4), f0 = *(const f32x4*)(FFg + o8), f1 = *(const f32x4*)(FFg + o8 + 4), k0 = *(const f32x4*)(FK + o8), k1 = *(const f32x4*)(FK + o8 + 4);
                const float iv = FI[t * 64 + vc]; const f32x2v iv2 = {iv, iv};
                s2[0] = f0.xy * s2[0] + k0.xy * iv2; s2[1] = f0.zw * s2[1] + k0.zw * iv2; s2[2] = f1.xy * s2[2] + k1.xy * iv2; s2[3] = f1.zw * s2[3] + k1.zw * iv2;
                f32x2v oa = s2[0] * q0.xy; oa = s2[1] * q0.zw + oa; oa = s2[2] * q1.xy + oa; oa = s2[3] * q1.zw + oa;
                const float o = red8(oa.x + oa.y);
                if (sub == 0) OO[t * 64 + vc] = o;
            }
            st[0] = s2[0].x; st[1] = s2[0].y; st[2] = s2[1].x; st[3] = s2[1].y; st[4] = s2[2].x; st[5] = s2[2].y; st[6] = s2[3].x; st[7] = s2[3].y;
        }
        __syncthreads();
#pragma unroll
        for (int i = 0; i < 4; ++i) { const int t = wave + 8 * i; if (t < len) { const int o = t * 64 + lane;
            const float ov = OO[o]; const float ms = wave_sum(ov * ov) * (1.f / 64.f);
            yabc[((size_t)q.row0 + t0 + t) * 1024 + 768 + h * 64 + lane] = f2bf(ov * rsqrtf(ms + 1e-6f) * hn * FO[o]); } }
        __syncthreads();
    }
    float* so = q.prompt ? P.out + O_HGP + (((size_t)layer * 8 + q.n) * 4 + h) * 4096 : P.out + O_HGS + (((size_t)layer * 128 + q.n) * 4 + h) * 4096;
#pragma unroll
    for (int j = 0; j < 8; ++j) so[(sub * 8 + j) * 64 + vc] = st[j];
}

struct S5Const { float bbr[16], bbi[16], cm[32], ar, ai, dsk; };
__device__ __forceinline__ void s5_const(PRef P, int layer, int g, int lane, S5Const& k) {
    const int p = lane;
    const float lr = P.in[I_LRE][(layer * 16 + g) * 64 + p], li = P.in[I_LIM][(layer * 16 + g) * 64 + p];
    const float dt = expf(P.in[I_LDT][layer * 16 + g]);
    const float mag = expf(lr * dt); const float ar = mag * cosf(li * dt), ai = mag * sinf(li * dt);
    const float den = lr * lr + li * li;
    const float zr = ((ar - 1.f) * lr + ai * li) / den, zi = (ai * lr - (ar - 1.f) * li) / den;
    const float* bre = P.in[I_BRE] + ((size_t)(layer * 16 + g) * 64 + p) * 16; const float* bim = P.in[I_BIM] + ((size_t)(layer * 16 + g) * 64 + p) * 16;
#pragma unroll
    for (int cc = 0; cc < 16; ++cc) { const float br = bre[cc], bi = bim[cc]; k.bbr[cc] = zr * br - zi * bi; k.bbi[cc] = zr * bi + zi * br; }
    const int cch = lane & 15, quad = lane >> 4;
    const float* cre = P.in[I_CRE] + ((size_t)(layer * 16 + g) * 16 + cch) * 64; const float* cim = P.in[I_CIM] + ((size_t)(layer * 16 + g) * 16 + cch) * 64;
#pragma unroll
    for (int kk = 0; kk < 32; ++kk) { const int qq = 4 * kk + quad; k.cm[kk] = qq < 64 ? cre[qq] : -cim[qq - 64]; }
    k.ar = ar; k.ai = ai; k.dsk = P.in[I_S5D][layer * 256 + g * 16 + cch];
}
template <bool FULL>
__device__ __forceinline__ void s5_chunk(PRef P, const S5Const& k, int g, int rowbase, int len, float& sr, float& si, float* wscr, int lane) {
    const bf16_t* zb = (const bf16_t*)(P.ws + WS_Z);
    bf16_t* ypre = (bf16_t*)(P.ws + WS_YPRE);
    float* U = wscr; float* Sm = wscr + 1024;
    LDS_FENCE();
    if (lane < len) { const u32x4 a = *(const u32x4*)(zb + (size_t)(rowbase + lane) * ZC + g * 16), b = *(const u32x4*)(zb + (size_t)(rowbase + lane) * ZC + g * 16 + 8);
        float* up = U + lane * 16;
        *(f32x4*)(up) = (f32x4){bflo(a.x), bfhi(a.x), bflo(a.y), bfhi(a.y)}; *(f32x4*)(up + 4) = (f32x4){bflo(a.z), bfhi(a.z), bflo(a.w), bfhi(a.w)};
        *(f32x4*)(up + 8) = (f32x4){bflo(b.x), bfhi(b.x), bflo(b.y), bfhi(b.y)}; *(f32x4*)(up + 12) = (f32x4){bflo(b.z), bfhi(b.z), bflo(b.w), bfhi(b.w)}; }
    LDS_FENCE();
    const int nsub = (len + 15) >> 4;
    for (int sb = 0; sb < nsub; ++sb) {
#pragma unroll 4
        for (int tt = 0; tt < 16; ++tt) {
            const int t = sb * 16 + tt;
            if (t < len) {
                const f32x4* up = (const f32x4*)(U + t * 16); const f32x4 u0 = up[0], u1 = up[1], u2 = up[2], u3 = up[3];
                float er = 0.f, ei = 0.f;
#pragma unroll
                for (int j = 0; j < 4; ++j) { er += k.bbr[j] * u0[j]; ei += k.bbi[j] * u0[j]; }
#pragma unroll
                for (int j = 0; j < 4; ++j) { er += k.bbr[4 + j] * u1[j]; ei += k.bbi[4 + j] * u1[j]; }
#pragma unroll
                for (int j = 0; j < 4; ++j) { er += k.bbr[8 + j] * u2[j]; ei += k.bbi[8 + j] * u2[j]; }
#pragma unroll
                for (int j = 0; j < 4; ++j) { er += k.bbr[12 + j] * u3[j]; ei += k.bbi[12 + j] * u3[j]; }
                const float nr = k.ar * sr - k.ai * si + er, ni = k.ar * si + k.ai * sr + ei;
                sr = nr; si = ni;
                if (FULL) { Sm[tt * 132 + lane] = sr; Sm[tt * 132 + 64 + lane] = si; }
            } else if (FULL) { Sm[tt * 132 + lane] = 0.f; Sm[tt * 132 + 64 + lane] = 0.f; }
        }
        if (FULL) {
            LDS_FENCE();
            const int row = lane & 15, quad = lane >> 4;
            f32x4 acc = {0.f, 0.f, 0.f, 0.f};
#pragma unroll
            for (int kk = 0; kk < 32; ++kk) acc = __builtin_amdgcn_mfma_f32_16x16x4f32(Sm[row * 132 + 4 * kk + quad], k.cm[kk], acc, 0, 0, 0);
#pragma unroll
            for (int j = 0; j < 4; ++j) { const int t = sb * 16 + quad * 4 + j;
                if (t < len) { const float y = acc[j] + k.dsk * U[t * 16 + row]; ypre[(size_t)(rowbase + t) * 256 + g * 16 + row] = f2bf(gelu_tanh(y)); } }
            LDS_FENCE();
        }
    }
}
__device__ __forceinline__ void cmul_acc(float ar, float ai, float& sr, float& si, float er, float ei) { const float nr = ar * sr - ai * si + er, ni = ar * si + ai * sr + ei; sr = nr; si = ni; }
__device__ __forceinline__ void s5_prompt_unit(PRef P, const Ctx& c, int layer, int n, int g) {
    S5Const k; s5_const(P, layer, g, c.lane, k);
    float* sm = (float*)c.lds;
    float* END = sm;
    float* wscr = sm + 1024 + c.wave * (1024 + 16 * 132);
    float a64r = k.ar, a64i = k.ai;
#pragma unroll
    for (int i = 0; i < 6; ++i) { const float r = a64r * a64r - a64i * a64i; float im = a64r * a64i; im += im; a64r = r; a64i = im; }
    float cr = 0.f, ci = 0.f;
    for (int round = 0; round < 4; ++round) {
        const int rowbase = n * 2048 + (round * 8 + c.wave) * 64;
        float lr_ = 0.f, li_ = 0.f;
        s5_chunk<false>(P, k, g, rowbase, 64, lr_, li_, wscr, c.lane);
        END[c.wave * 128 + c.lane] = lr_; END[c.wave * 128 + 64 + c.lane] = li_;
        __syncthreads();
        float sr = cr, si = ci, ar_ = cr, ai_ = ci;
        for (int w = 0; w < 8; ++w) { const float er = END[w * 128 + c.lane], ei = END[w * 128 + 64 + c.lane];
            if (w < c.wave) cmul_acc(a64r, a64i, sr, si, er, ei);
            cmul_acc(a64r, a64i, ar_, ai_, er, ei); }
        cr = ar_; ci = ai_;
        __syncthreads();
        s5_chunk<true>(P, k, g, rowbase, 64, sr, si, wscr, c.lane);
    }
    if (c.wave == 0) { float* o = P.out + O_S5P + (((size_t)layer * 8 + n) * 16 + g) * 128 + c.lane * 2; o[0] = cr; o[1] = ci; }
    __syncthreads();
}
__device__ __forceinline__ void s5_sample_wave(PRef P, const Ctx& c, int layer, int n, int g) {
    S5Const k; s5_const(P, layer, g, c.lane, k);
    float* wscr = (float*)c.lds + 1024 + c.wave * (1024 + 16 * 132);
    const float* sp = P.in[I_SS5] + (((size_t)layer * 128 + n) * 16 + g) * 128 + c.lane * 2;
    float sr = sp[0], si = sp[1];
    s5_chunk<true>(P, k, g, TP + n * 4, 4, sr, si, wscr, c.lane);
    float* o = P.out + O_S5S + (((size_t)layer * 128 + n) * 16 + g) * 128 + c.lane * 2; o[0] = sr; o[1] = si;
}

__device__ __forceinline__ void phase_scan(PRef P, const Ctx& c, int layer) {
    for (int u = c.b; u < 224; u += c.G) {
        if (u < 64) rwkv_unit(P, c, layer, u >> 3, u & 7);
        else if (u < 96) hgrn_unit(P, c, layer, (u - 64) >> 2, (u - 64) & 3);
        else s5_prompt_unit(P, c, layer, (u - 96) >> 4, (u - 96) & 15);
    }
    if (c.G == 256 && c.b >= 224) { Ctx cc = c; cc.b = c.b - 224; cc.G = 32; convert_layer_weights(P, cc, layer, 2); if (layer == 0) convert_layer_weights(P, cc, 1, 1); __syncthreads(); }
    const int nb = c.G > 96 ? c.G - 96 : c.G, sb = c.G > 96 ? c.b - 96 : c.b;
    if (sb >= 0) for (int j = sb; j < 1792; j += nb) {
        if (j < 1024) rwkv_unit(P, c, layer, 8 + (j >> 3), j & 7);
        else if (j < 1536) hgrn_unit(P, c, layer, 8 + ((j - 1024) >> 2), (j - 1024) & 3);
        else { const int w = (j - 1536) * 8 + c.wave; s5_sample_wave(P, c, layer, w >> 4, w & 15); __syncthreads(); }
    }
}

__device__ __forceinline__ void unpack8(const u32x4 w, float* x) { x[0] = bflo(w.x); x[1] = bfhi(w.x); x[2] = bflo(w.y); x[3] = bfhi(w.y); x[4] = bflo(w.z); x[5] = bfhi(w.z); x[6] = bflo(w.w); x[7] = bfhi(w.w); }
__device__ __forceinline__ void phase_conv(PRef P, const Ctx& c, int layer) {
    bf16_t* up = (bf16_t*)(P.ws + WS_UP); const bf16_t* halo = (const bf16_t*)(P.ws + WS_HALO);
    const float* cw = P.in[I_CW] + (size_t)layer * 3 * FF2; const float* cb = P.in[I_CB] + (size_t)layer * FF2;
    const int cgp = c.tid & 31, seg = c.tid >> 5;
    for (int item = c.b; item < 66 * 11; item += c.G) {
        const int pm = item / 11, strip = item - pm * 11; const int c0 = strip * 256 + cgp * 8;
        const int r0 = pm * 256 + seg * 16;
        float wa[3][8], wb[3][8], ba[8], bb[8];
#pragma unroll
        for (int j = 0; j < 3; ++j)
#pragma unroll
            for (int e = 0; e < 8; ++e) { wa[j][e] = cw[j * FF2 + c0 + e]; wb[j][e] = cw[j * FF2 + FF + c0 + e]; }
#pragma unroll
        for (int e = 0; e < 8; ++e) { ba[e] = cb[c0 + e]; bb[e] = cb[FF + c0 + e]; }
        float p2a[8], p2b[8], p1a[8], p1b[8];
        {
            const int tl = r0 < TP ? (r0 & 2047) : ((r0 - TP) & 3);
            if (tl == 0) {
#pragma unroll
                for (int e = 0; e < 8; ++e) { p2a[e] = p2b[e] = p1a[e] = p1b[e] = 0.f; }
            } else {
                const bf16_t* s2 = seg > 0 ? up + (size_t)(r0 - 2) * FF2 : halo + ((size_t)(pm - 1) * 2 + 0) * FF2;
                const bf16_t* s1 = seg > 0 ? up + (size_t)(r0 - 1) * FF2 : halo + ((size_t)(pm - 1) * 2 + 1) * FF2;
                unpack8(*(const u32x4*)(s2 + c0), p2a); unpack8(*(const u32x4*)(s2 + FF + c0), p2b); unpack8(*(const u32x4*)(s1 + c0), p1a); unpack8(*(const u32x4*)(s1 + FF + c0), p1b);
            }
        }
        __syncthreads();
        for (int rb = 0; rb < 4; ++rb) {
            u32x4 ra[4], rbv[4];
#pragma unroll
            for (int i = 0; i < 4; ++i) { const size_t row = (size_t)r0 + rb * 4 + i; ra[i] = *(const u32x4*)(up + row * FF2 + c0); rbv[i] = *(const u32x4*)(up + row * FF2 + FF + c0); }
#pragma unroll
            for (int i = 0; i < 4; ++i) { const int row = r0 + rb * 4 + i;
                const int tl = row < TP ? (row & 2047) : ((row - TP) & 3);
                if (tl == 0) {
                    if (row < TP) {
#pragma unroll
                        for (int e = 0; e < 8; ++e) { p2a[e] = p2b[e] = p1a[e] = p1b[e] = 0.f; }
                    } else { const float* sp = P.in[I_SCV] + ((size_t)layer * 128 + ((row - TP) >> 2)) * 2 * FF2;
#pragma unroll
                        for (int e = 0; e < 8; ++e) { p2a[e] = sp[c0 + e]; p2b[e] = sp[FF + c0 + e]; p1a[e] = sp[FF2 + c0 + e]; p1b[e] = sp[FF2 + FF + c0 + e]; } }
                }
                float ca[8], cbv[8], o[8]; unpack8(ra[i], ca); unpack8(rbv[i], cbv);
#pragma unroll
                for (int e = 0; e < 8; ++e) { const float xa = ba[e] + wa[0][e] * p2a[e] + wa[1][e] * p1a[e] + wa[2][e] * ca[e]; const float xb = bb[e] + wb[0][e] * p2b[e] + wb[1][e] * p1b[e] + wb[2][e] * cbv[e];
                    o[e] = gelu_tanh(xa) * xb; p2a[e] = p1a[e]; p2b[e] = p1b[e]; p1a[e] = ca[e]; p1b[e] = cbv[e]; }
                u32x4 w; w.x = cvt_pk_bf16(o[0], o[1]); w.y = cvt_pk_bf16(o[2], o[3]); w.z = cvt_pk_bf16(o[4], o[5]); w.w = cvt_pk_bf16(o[6], o[7]);
                *(u32x4*)(up + (size_t)row * FF2 + c0) = w; }
        }
        __syncthreads();
    }
}

#define XB_TMO      128
#define XB_XCNT(j)  (256  + 64 * (j))
#define XB_XSUB(j)  (1280 + 64 * (j))
#define XB_XGEN(j)  (2304 + 64 * (j))
#define XB_TOP      3328
#define XB_TOPGEN   3392
#define XCD_BAR_WORDS 3456
#define XB_SPIN_CAP (1u << 18)

__device__ __forceinline__ unsigned xb_ld(unsigned* p)              { return __hip_atomic_load(p, __ATOMIC_RELAXED, __HIP_MEMORY_SCOPE_AGENT); }
__device__ __forceinline__ unsigned xb_add(unsigned* p, unsigned v) { return __hip_atomic_fetch_add(p, v, __ATOMIC_RELAXED, __HIP_MEMORY_SCOPE_AGENT); }
__device__ __forceinline__ unsigned xb_xcc_id() { return (unsigned)__builtin_amdgcn_s_getreg((3 << 11) | 20) & 0xFu; }
#define XB_SPIN(cond, bar) do { unsigned _sp = 0; while (cond) { __builtin_amdgcn_s_sleep(1); \
    if ((++_sp & 255u) == 0u) { if (xb_ld(&(bar)[XB_TMO])) break; if (_sp > XB_SPIN_CAP) { atomicAdd(&(bar)[XB_TMO], 1u); break; } } } } while (0)

struct XcdBarrier {
    unsigned* bar; unsigned x;
    volatile LAS unsigned* st;
};

__device__ __forceinline__ XcdBarrier xcd_barrier_post(unsigned* bar, volatile LAS unsigned* st) {
    XcdBarrier b; b.bar = bar; b.x = xb_xcc_id(); b.st = st;
    if (threadIdx.x == 0) (void)xb_add(&bar[XB_XCNT(b.x)], 1u);
    return b;
}
__device__ __forceinline__ void xcd_barrier_complete(unsigned* bar, unsigned x, unsigned& nloc, unsigned& nx) {
    const unsigned G = gridDim.x * gridDim.y * gridDim.z;
    unsigned sum, cnt, mine, sp = 0u;
    for (;;) {
        sum = 0u; cnt = 0u; mine = 0u;
#pragma unroll
        for (unsigned j = 0; j < 16; ++j) { const unsigned c = xb_ld(&bar[XB_XCNT(j)]); sum += c; cnt += (c > 0u) ? 1u : 0u; mine = (j == x) ? c : mine; }
        if (sum == G) break;
        __builtin_amdgcn_s_sleep(1);
        if ((++sp & 255u) == 0u) { if (xb_ld(&bar[XB_TMO])) break; if (sp > XB_SPIN_CAP) { atomicAdd(&bar[XB_TMO], 1u); break; } }
    }
    nloc = mine > 0u ? mine : 1u; nx = cnt > 0u ? cnt : 1u;
}

__device__ __forceinline__ void xcd_barrier(const XcdBarrier& b) {
    asm volatile("s_waitcnt vmcnt(0)" ::: "memory");
    __syncthreads();
    if (threadIdx.x == 0) {
        unsigned* bar = b.bar;
        __builtin_amdgcn_s_waitcnt(0);
        unsigned nloc = b.st[0], nx = b.st[1];
        if (nloc == 0u) { xcd_barrier_complete(bar, b.x, nloc, nx); b.st[0] = nloc; b.st[1] = nx; }
        const unsigned old = xb_add(&bar[XB_XSUB(b.x)], 1u);
        const unsigned gen = old / nloc;
        if (old + 1u == (gen + 1u) * nloc) {
            __builtin_amdgcn_fence(__ATOMIC_RELEASE, "agent");
            asm volatile("s_waitcnt vmcnt(0)" ::: "memory");
            const unsigned og = xb_add(&bar[XB_TOP], 1u);
            const unsigned tg = og / nx;
            if (og + 1u == (tg + 1u) * nx) xb_add(&bar[XB_TOPGEN], 1u);
            else XB_SPIN(xb_ld(&bar[XB_TOPGEN]) == tg, bar);
            __builtin_amdgcn_fence(__ATOMIC_ACQUIRE, "agent");
            xb_add(&bar[XB_XGEN(b.x)], 1u);
            asm volatile("s_waitcnt vmcnt(0)" ::: "memory");
        } else {
            XB_SPIN(xb_ld(&bar[XB_XGEN(b.x)]) == gen, bar);
            __builtin_amdgcn_fence(__ATOMIC_ACQUIRE, "agent");
            asm volatile("s_waitcnt vmcnt(0)" ::: "memory");
        }
    }
    __syncthreads();
}
constexpr int N_PHASES = 2 + 10 * 2 + 1;
__device__ __forceinline__ void run_phase(PRef P, const Ctx& c, int ph) {
    unsigned char* ws = P.ws;
    float* mod = (float*)(ws + WS_MOD);
    bf16_t* H = (bf16_t*)(ws + WS_H);
    bf16_t* zb = (bf16_t*)(ws + WS_Z); bf16_t* gb = (bf16_t*)(ws + WS_G); bf16_t* up = (bf16_t*)(ws + WS_UP);
    if (ph == 0) { phase_start(P, c); return; }
    if (ph == 1) { EpiAda E{mod, P.in[I_BADA]}; run_gemm(c, (const bf16_t*)(ws + WS_AADA), 1024, (const bf16_t*)(ws + WS_WADA), 256, 12288, 1024, E); return; }
    if (ph == N_PHASES - 1) { phase_final_norm(P, c); return; }
    const int layer = (ph - 2) / 10, sp = (ph - 2) % 10;
    switch (sp) {
    case 0: phase_norm(P, c, layer, 0, layer == 0); if (layer > 0 && c.G != 256) convert_layer_weights(P, c, layer, 0); break;
    case 1: { EpiZ E{zb, gb, P.out, layer}; run_gemm(c, H, 1024, (const bf16_t*)(ws + WS_WIN), T, INP, 1024, E); } break;
    case 2: phase_scan(P, c, layer); break;
    case 3: { EpiGlu E{(const bf16_t*)(ws + WS_YPRE), H, P.in[I_BGLU] + layer * 256}; run_gemm(c, (const bf16_t*)(ws + WS_YPRE), 256, (const bf16_t*)(ws + WS_WGLU), T, 256, 256, E); } break;
    case 4: { EpiLift E0{gb, 0}; run_gemm(c, H, 1024, (const bf16_t*)(ws + WS_LA), T, 1024, 256, E0);
              EpiLift E1{gb, 1}; run_gemm(c, H + 256, 1024, (const bf16_t*)(ws + WS_LB), T, 1024, 512, E1);
              EpiLift E2{gb, 2}; run_gemm(c, H + 768, 1024, (const bf16_t*)(ws + WS_LC), T, 1024, 256, E2); } break;
    case 5: { EpiRes E{P.out, mod + (size_t)layer * NSEQ * 6144 + 2 * 1024}; run_gemm(c, gb, GC, (const bf16_t*)(ws + WS_WOUT3), T, 1024, 1024, E); } break;
    case 6: phase_norm(P, c, layer, 1, false); break;
    case 7: { EpiUp E{up, (bf16_t*)(ws + WS_HALO), P.out, layer}; run_gemm(c, H, 1024, (const bf16_t*)(ws + WS_WUP), T, FF2, 1024, E); } break;
    case 8: phase_conv(P, c, layer); break;
    case 9: { EpiRes E{P.out, mod + (size_t)layer * NSEQ * 6144 + 5 * 1024}; run_gemm(c, up, FF2, (const bf16_t*)(ws + WS_WDN), T, 1024, FF, E); } break;
    }
}

__global__ void __launch_bounds__(NTHREADS, 2) fwd_kernel(Params P, int ph_lo, int ph_hi) {
    extern __shared__ __attribute__((aligned(16))) unsigned char shm[];
    volatile LAS unsigned* bst = (volatile LAS unsigned*)((LAS unsigned char*)shm + (LDS_BYTES - 8));
    if (threadIdx.x == 0) { bst[0] = 0u; bst[1] = 0u; }
    __syncthreads();
    const XcdBarrier gbar = xcd_barrier_post((unsigned*)(P.ws + WS_BAR), bst);
    const int wave_s = __builtin_amdgcn_readfirstlane(threadIdx.x >> 6);
    for (int ph = ph_lo; ph < ph_hi; ++ph) {
        int lane_; asm volatile("v_mbcnt_lo_u32_b32 %0, -1, 0\n\tv_mbcnt_hi_u32_b32 %0, -1, %0" : "=v"(lane_));
        int tid_ = wave_s * 64 + lane_; asm volatile("" : "+v"(tid_));
        int bid_ = blockIdx.x; asm volatile("" : "+s"(bid_));
        Ctx c; c.tid = tid_; c.lane = tid_ & 63; c.wave = __builtin_amdgcn_readfirstlane(tid_ >> 6); c.b = bid_; c.G = gridDim.x; c.lds = shm;
        const __attribute__((address_space(4))) Params* kp = (const __attribute__((address_space(4))) Params*)__builtin_amdgcn_kernarg_segment_ptr();
        asm volatile("" : "+s"(kp));
        run_phase(*kp, c, ph);
        if (ph + 1 < ph_hi) xcd_barrier(gbar);
    }
}

extern "C" void kernel_launch(void* const* d_in, const int* in_sizes, int n_in, void* d_out, int out_size, void* d_ws, size_t ws_size, hipStream_t stream) {
    static int grid = 0;
    if (grid == 0) {
        int dev = 0, cus = 0, per_cu = 0;
        (void)hipGetDevice(&dev); (void)hipDeviceGetAttribute(&cus, hipDeviceAttributeMultiprocessorCount, dev);
        (void)hipFuncSetAttribute((const void*)fwd_kernel, hipFuncAttributeMaxDynamicSharedMemorySize, LDS_BYTES);
        (void)hipOccupancyMaxActiveBlocksPerMultiprocessor(&per_cu, (const void*)fwd_kernel, NTHREADS, LDS_BYTES);
        (void)hipGetLastError();
        if (per_cu < 1) per_cu = 1;
        grid = cus;
        if (ws_size < WS_END) fprintf(stderr, "kernel_launch: workspace too small: %zu < %zu\n", ws_size, (size_t)WS_END);
        if (n_in != 46) fprintf(stderr, "kernel_launch: expected 46 inputs, got %d\n", n_in);
    }
    if (ws_size < WS_END || n_in != 46) return;
    Params p{};
    for (int i = 0; i < 46; ++i) p.in[i] = (const float*)d_in[i];
    p.out = (float*)d_out; p.ws = (unsigned char*)d_ws;
#if N_LAUNCH_MODE == 1
    (void)hipMemsetAsync((unsigned char*)d_ws + WS_BAR, 0, XCD_BAR_WORDS * 4, stream);
    int lo = 0, hi = N_PHASES;
    void* args[] = {&p, &lo, &hi};
    hipError_t e = hipLaunchCooperativeKernel((const void*)fwd_kernel, dim3(grid), dim3(NTHREADS), args, LDS_BYTES, stream);
    if (e != hipSuccess) fprintf(stderr, "cooperative launch failed: %s (grid %d)\n", hipGetErrorString(e), grid);
#else
    for (int ph = 0; ph < N_PHASES; ++ph) hipLaunchKernelGGL(fwd_kernel, dim3(grid), dim3(NTHREADS), LDS_BYTES, stream, p, ph, ph + 1);
#endif
}
```

```cpp
#include <hip/hip_runtime.h>
#include <hip/hip_cooperative_groups.h>
#include <cstdio>
#include <cstdint>
namespace cg = cooperative_groups;

#ifndef N_LAUNCH_MODE
#define N_LAUNCH_MODE 1
#endif

#define LAS __attribute__((address_space(3)))
typedef unsigned short bf16_t;
typedef short bf16x8 __attribute__((ext_vector_type(8)));
typedef float f32x4 __attribute__((ext_vector_type(4)));
typedef unsigned u32x4 __attribute__((ext_vector_type(4)));
typedef unsigned u32x2 __attribute__((ext_vector_type(2)));
typedef float f32x2v __attribute__((ext_vector_type(2)));

constexpr int D = 1024, TP = 16384, TS = 512, T = TP + TS, NSEQ = 136;
constexpr int ZC = 2944, GC = 3072, INC = 6016, INP = 6144, FF = 2816, FF2 = 5632, RWC = 1664;
constexpr int NTHREADS = 512, NWAVES = 8;
constexpr int LDS_BYTES = 147456;

constexpr size_t O_YP = 0, O_YS = 16777216, O_S5P = 17301504, O_SHP = 17334272, O_RWP = 17360896, O_HGP = 17885184, O_CVP = 18147328,
                 O_S5S = 18327552, O_SHS = 18851840, O_RWS = 19277824, O_HGS = 27666432, O_CVS = 31860736;

constexpr size_t WS_MOD = 4096;
constexpr size_t WS_WIN = WS_MOD + (size_t)2 * NSEQ * 6144 * 4;
constexpr size_t WS_LA = WS_WIN + (size_t)INP * 1024 * 2;
constexpr size_t WS_LB = WS_LA + (size_t)1024 * 256 * 2;
constexpr size_t WS_LC = WS_LB + (size_t)1024 * 512 * 2;
constexpr size_t WS_WGLU = WS_LC + (size_t)1024 * 256 * 2;
constexpr size_t WS_WOUT3 = WS_WGLU + (size_t)256 * 256 * 2;
constexpr size_t WS_WUP = WS_WOUT3 + (size_t)1024 * 3072 * 2;
constexpr size_t WS_WDN = WS_WUP + (size_t)FF2 * 1024 * 2;
constexpr size_t WS_H = WS_WDN + (size_t)1024 * FF * 2;
constexpr size_t WS_YPRE = WS_H + (size_t)T * 1024 * 2;
constexpr size_t WS_HALO = WS_YPRE + (size_t)T * 256 * 2;
constexpr size_t WS_BIG = WS_HALO + (size_t)66 * 2 * FF2 * 2;
constexpr size_t WS_Z = WS_BIG, WS_G = WS_Z + (size_t)T * ZC * 2, WS_UP = WS_BIG;
constexpr size_t WS_WADA = WS_BIG, WS_AADA = WS_WADA + (size_t)12288 * 1024 * 2;
constexpr size_t WS_BAR = WS_G + (size_t)T * GC * 2;
constexpr size_t WS_END = WS_BAR + 16384;

struct Params { const float* in[46]; float* out; unsigned char* ws; };
typedef const __attribute__((address_space(4))) Params& PRef;

enum { I_XP = 0, I_XS, I_CP, I_CS, I_SS5, I_SSH, I_SRW, I_SHG, I_SCV, I_WADA, I_BADA, I_GMIX, I_GFFN, I_WIN, I_LRE, I_LIM, I_LDT, I_BRE, I_BIM, I_CRE, I_CIM, I_S5D, I_WGLU, I_BGLU,
       I_MU, I_W0, I_W2, I_A0, I_A2, I_G2, I_KK, I_KA, I_RK, I_LNW, I_LNB, I_HLB, I_HNORM, I_LFA, I_LFB, I_LFC, I_WOUT, I_WUP, I_CW, I_CB, I_WDN, I_FG };

__device__ __forceinline__ unsigned short f2bf(float f) { unsigned u = __float_as_uint(f); u += 0x7FFFu + ((u >> 16) & 1u); return (unsigned short)(u >> 16); }
__device__ __forceinline__ float bf2f(unsigned short b) { return __uint_as_float(((unsigned)b) << 16); }
__device__ __forceinline__ float bflo(unsigned w) { return __uint_as_float(w << 16); }
__device__ __forceinline__ float bfhi(unsigned w) { return __uint_as_float(w & 0xFFFF0000u); }
typedef __bf16 bf16x2_t __attribute__((ext_vector_type(2)));
__device__ __forceinline__ unsigned cvt_pk_bf16(float lo, float hi) {
    bf16x2_t v; v.x = (__bf16)lo; v.y = (__bf16)hi; return __builtin_bit_cast(unsigned, v); }
__device__ __forceinline__ float fsigmoid(float x) { return __builtin_amdgcn_rcpf(1.0f + __expf(-x)); }
__device__ __forceinline__ float gelu_tanh(float x) { return x * fsigmoid(1.5957691216f * (x + 0.044715f * x * x * x)); }
#define DPP_ADD(v, CTRL) ((v) + __int_as_float(__builtin_amdgcn_update_dpp(0, __float_as_int(v), (CTRL), 0xF, 0xF, true)))
__device__ __forceinline__ float wave_sum(float v) {
    v = DPP_ADD(v, 0xB1); v = DPP_ADD(v, 0x4E); v = DPP_ADD(v, 0x141); v = DPP_ADD(v, 0x140);
    const float r0 = __int_as_float(__builtin_amdgcn_readlane(__float_as_int(v), 0)), r1 = __int_as_float(__builtin_amdgcn_readlane(__float_as_int(v), 16));
    const float r2 = __int_as_float(__builtin_amdgcn_readlane(__float_as_int(v), 32)), r3 = __int_as_float(__builtin_amdgcn_readlane(__float_as_int(v), 48));
    return (r0 + r1) + (r2 + r3);
}
__device__ __forceinline__ float red8(float v) { v = DPP_ADD(v, 0xB1); v = DPP_ADD(v, 0x4E); v = DPP_ADD(v, 0x141); return v; }
__device__ __forceinline__ int row2seq(int row) { return row < TP ? (row >> 11) : 8 + ((row - TP) >> 2); }
#define LDS_FENCE() asm volatile("s_waitcnt lgkmcnt(0)" ::: "memory")

namespace pg8 {
constexpr int BM = 256, BK = 64, HALF = 128, HTB = HALF * BK * 2, STAGE_BYTES = 8 * HTB, NXCD = 8, WGM = 8;
__host__ __device__ __forceinline__ int lds_byte(int r, int c) { const int st = (r >> 4) * 2 + (c >> 5), rr = r & 15, cc = c & 31, ob = rr * 64 + cc * 2; return st * 1024 + (ob ^ (((ob >> 9) & 1) << 5)); }
__host__ __device__ __forceinline__ void stage_rc(int b, int& R, int& C) { const int st = b / 1024, sb = b % 1024, swz = sb ^ (((sb >> 9) & 1) << 5); R = (st >> 1) * 16 + swz / 64; C = (st & 1) * 32 + (swz % 64) / 2; }
__host__ __device__ __forceinline__ int perm32(int rho) { const int n = rho >> 4, i = rho & 15; return 8 * (i >> 2) + 4 * n + (i & 3); }
struct Unit { int pm, pn; };
struct Gemm { const bf16_t* A; const bf16_t* Bt; int M, N, K, lda; };
struct StaticOrder {
    int nM, nN, nwg, G, c;
    __device__ void init(int M, int N, int G_, int c_) { nM = M / BM; nN = N / BM; nwg = nM * nN; G = G_; c = c_; }
    __device__ bool next(int i, Unit& u) const {
        const long L = (long)i * G + c; if (L >= nwg) return false;
        int wgid = (int)L; { const int q = nwg / NXCD, r = nwg % NXCD, xcd = wgid % NXCD, off = wgid / NXCD; wgid = (xcd < r ? xcd * (q + 1) : r * (q + 1) + (xcd - r) * q) + off; }
        const int nig = WGM * nN, gid = wgid / nig, fm = gid * WGM, gsz = (nM - fm) < WGM ? (nM - fm) : WGM;
        u.pm = fm + ((wgid % nig) % gsz); u.pn = (wgid % nig) / gsz; return true;
    }
};

template <class Epi>
__device__ __forceinline__ void gemm_phase(LAS unsigned char* lds, const Gemm g, const StaticOrder& S, const Epi& E, const int tid) {
    const int wid = __builtin_amdgcn_readfirstlane(tid >> 6), lane = tid & 63, wr = wid >> 2, wc = wid & 3, fr = lane & 15, fq = lane >> 4;
    const int K = g.K, nt = K / BK, lda = g.lda;
    unsigned voffA[2], voffB[2];
#pragma unroll
    for (int i = 0; i < 2; ++i) { int R, C; stage_rc(tid * 16 + i * 8192, R, C); const int Rb = Epi::PERM ? ((R & ~31) + perm32(R & 31)) : R;
        voffA[i] = (unsigned)(R * lda + C) * 2u; voffB[i] = (unsigned)(Rb * K + C) * 2u; }
    const size_t kstep = (size_t)(BK * 2);
    const size_t hstepA = (size_t)HALF * lda * 2, hstepB = (size_t)HALF * K * 2;
    const size_t tstepA = 2 * hstepA, tstepB = 2 * hstepB;
    const unsigned ldsw = (unsigned)wid * 1024u;
    const int aoff = lds_byte(wr * 64 + fr, fq * 8), boff = lds_byte(wc * 32 + fr, fq * 8);
#define PG8_SA(b, h) (((b) * 2 + (h)) * HTB)
#define PG8_SB(b, h) ((4 + (b) * 2 + (h)) * HTB)
#define PG8_STAGE(bufoff, gbase, voff) do { _Pragma("unroll") for (int _i = 0; _i < 2; ++_i) \
        __builtin_amdgcn_global_load_lds((const unsigned*)((const char*)(gbase) + (voff)[_i]), (LAS unsigned*)(lds + (bufoff) + ldsw + _i * 8192), 16, 0, 0); } while (0)
#define PG8_LDA(dst, b, h) do { _Pragma("unroll") for (int m = 0; m < 4; ++m) _Pragma("unroll") for (int k = 0; k < 2; ++k) dst[m][k] = *(const LAS bf16x8*)(lds + PG8_SA(b, h) + aoff + m * 2048 + k * 1024); } while (0)
#define PG8_LDB(dst, b, h) do { _Pragma("unroll") for (int n = 0; n < 2; ++n) _Pragma("unroll") for (int k = 0; k < 2; ++k) dst[n][k] = *(const LAS bf16x8*)(lds + PG8_SB(b, h) + boff + n * 2048 + k * 1024); } while (0)
#define PG8_MMA(ai, bj, At, Bt) do { __builtin_amdgcn_s_setprio(1); _Pragma("unroll") for (int m = 0; m < 4; ++m) _Pragma("unroll") for (int n = 0; n < 2; ++n) _Pragma("unroll") for (int k = 0; k < 2; ++k) \
        acc[ai][bj][m][n] = __builtin_amdgcn_mfma_f32_16x16x32_bf16(Bt[n][k], At[m][k], acc[ai][bj][m][n], 0, 0, 0); __builtin_amdgcn_s_setprio(0); } while (0)
#define PG8_WAIT_V(n) asm volatile("s_waitcnt vmcnt(" #n ")" ::: "memory")
#define PG8_WAIT_L(n) asm volatile("s_waitcnt lgkmcnt(" #n ")" ::: "memory")
#define PG8_BAR __builtin_amdgcn_s_barrier()
#define PG8_SCHED __builtin_amdgcn_sched_barrier(0)
    Unit cur, nxt; int ui = 0;
    if (!S.next(0, cur)) return;
    f32x4 acc[2][2][4][2];
#pragma unroll
    for (int a = 0; a < 2; ++a)
#pragma unroll
        for (int b = 0; b < 2; ++b)
#pragma unroll
            for (int m = 0; m < 4; ++m)
#pragma unroll
                for (int n = 0; n < 2; ++n) acc[a][b][m][n] = (f32x4){0.f, 0.f, 0.f, 0.f};
    bf16x8 At[4][2], B0[2][2], B1[2][2];
    const char* cA = (const char*)g.A + (size_t)cur.pm * tstepA; const char* cB = (const char*)g.Bt + (size_t)cur.pn * tstepB;
    PG8_STAGE(PG8_SB(0, 0), cB, voffB); PG8_STAGE(PG8_SA(0, 0), cA, voffA); PG8_STAGE(PG8_SB(0, 1), cB + hstepB, voffB); PG8_STAGE(PG8_SA(0, 1), cA + hstepA, voffA);
    if (wr == 1) PG8_BAR;
    PG8_WAIT_V(4); PG8_BAR;
    PG8_STAGE(PG8_SB(1, 0), cB + kstep, voffB); PG8_STAGE(PG8_SA(1, 0), cA + kstep, voffA); PG8_STAGE(PG8_SB(1, 1), cB + hstepB + kstep, voffB);
    PG8_WAIT_V(6); PG8_BAR;
    for (;;) {
        const bool has_next = S.next(ui + 1, nxt);
        const char* nA = has_next ? (const char*)g.A + (size_t)nxt.pm * tstepA : cA; const char* nB = has_next ? (const char*)g.Bt + (size_t)nxt.pn * tstepB : cB;
        for (int t = 0; t < nt; t += 2) {
            const bool last = (t == nt - 2);
            const char* a1 = cA + (size_t)(t + 1) * kstep;
            const char* a2 = last ? nA : cA + (size_t)(t + 2) * kstep; const char* b2 = last ? nB : cB + (size_t)(t + 2) * kstep;
            const char* a3 = a2 + kstep; const char* b3 = b2 + kstep;
            PG8_LDB(B0, 0, 0); PG8_SCHED; PG8_LDA(At, 0, 0); PG8_STAGE(PG8_SA(1, 1), a1 + hstepA, voffA);
            PG8_WAIT_L(8); PG8_BAR; PG8_WAIT_L(0); PG8_MMA(0, 0, At, B0); PG8_BAR; PG8_SCHED;
            PG8_LDB(B1, 0, 1); PG8_STAGE(PG8_SB(0, 0), b2, voffB);
            PG8_BAR; PG8_WAIT_L(0); PG8_MMA(0, 1, At, B1); PG8_BAR;
            PG8_LDA(At, 0, 1); PG8_STAGE(PG8_SA(0, 0), a2, voffA);
            PG8_BAR; PG8_WAIT_L(0); PG8_MMA(1, 0, At, B0); PG8_BAR; PG8_SCHED;
            PG8_STAGE(PG8_SB(0, 1), b2 + hstepB, voffB);
            PG8_WAIT_V(6); PG8_BAR; PG8_MMA(1, 1, At, B1); PG8_BAR;
            PG8_LDB(B0, 1, 0); PG8_SCHED; PG8_LDA(At, 1, 0); PG8_STAGE(PG8_SA(0, 1), a2 + hstepA, voffA);
            PG8_WAIT_L(8); PG8_BAR; PG8_WAIT_L(0); PG8_MMA(0, 0, At, B0); PG8_BAR; PG8_SCHED;
            PG8_LDB(B1, 1, 1); PG8_STAGE(PG8_SB(1, 0), b3, voffB);
            PG8_BAR; PG8_WAIT_L(0); PG8_MMA(0, 1, At, B1); PG8_BAR;
            PG8_LDA(At, 1, 1); PG8_STAGE(PG8_SA(1, 0), a3, voffA);
            PG8_BAR; PG8_WAIT_L(0); PG8_MMA(1, 0, At, B0); PG8_BAR; PG8_SCHED;
            PG8_STAGE(PG8_SB(1, 1), b3 + hstepB, voffB);
            PG8_WAIT_V(6); PG8_BAR; PG8_MMA(1, 1, At, B1); PG8_BAR;
        }
        { int fr_ = fr, fq_ = fq; asm volatile("" : "+v"(fr_), "+v"(fq_));
          E(acc, cur, wr, wc, fr_, fq_); }
        if (!has_next) break;
#pragma unroll
        for (int a = 0; a < 2; ++a)
#pragma unroll
            for (int b = 0; b < 2; ++b)
#pragma unroll
                for (int m = 0; m < 4; ++m)
#pragma unroll
                    for (int n = 0; n < 2; ++n) acc[a][b][m][n] = (f32x4){0.f, 0.f, 0.f, 0.f};
        cur = nxt; cA = nA; cB = nB; ++ui;
    }
    PG8_WAIT_V(0);
    if (wr == 0) PG8_BAR;
    PG8_BAR;
#undef PG8_SA
#undef PG8_SB
#undef PG8_STAGE
#undef PG8_LDA
#undef PG8_LDB
#undef PG8_MMA
#undef PG8_WAIT_V
#undef PG8_WAIT_L
#undef PG8_BAR
#undef PG8_SCHED
}
}
using pg8::Unit;
typedef f32x4 AccT[2][2][4][2];

#define EPI_LOOP_PERM(...) \
    _Pragma("unroll") for (int ai = 0; ai < 2; ++ai) _Pragma("unroll") for (int m = 0; m < 4; ++m) { const int row = u.pm * 256 + ai * 128 + wr * 64 + m * 16 + fr; \
        _Pragma("unroll") for (int bj = 0; bj < 2; ++bj) { const int col0 = u.pn * 256 + bj * 128 + wc * 32 + 8 * fq; const f32x4 v0 = acc[ai][bj][m][0], v1 = acc[ai][bj][m][1]; __VA_ARGS__ } }
#define EPI_LOOP_NOPERM(...) \
    _Pragma("unroll") for (int ai = 0; ai < 2; ++ai) _Pragma("unroll") for (int m = 0; m < 4; ++m) { const int row = u.pm * 256 + ai * 128 + wr * 64 + m * 16 + fr; \
        _Pragma("unroll") for (int bj = 0; bj < 2; ++bj) _Pragma("unroll") for (int n = 0; n < 2; ++n) { const int col0 = u.pn * 256 + bj * 128 + wc * 32 + 16 * n + 4 * fq; const f32x4 v = acc[ai][bj][m][n]; __VA_ARGS__ } }

__device__ __forceinline__ u32x4 pack8(f32x4 a, f32x4 b) { u32x4 w; w.x = cvt_pk_bf16(a[0], a[1]); w.y = cvt_pk_bf16(a[2], a[3]); w.z = cvt_pk_bf16(b[0], b[1]); w.w = cvt_pk_bf16(b[2], b[3]); return w; }

struct EpiAda {
    static constexpr bool PERM = false;
    float* mod; const float* bada;
    __device__ __forceinline__ void operator()(const AccT& acc, const Unit& u, int wr, int wc, int fr, int fq) const {
        EPI_LOOP_NOPERM( if (row < NSEQ) { const int layer = col0 / 6144, c = col0 - layer * 6144; const f32x4 b = *(const f32x4*)(bada + (size_t)layer * 6144 + c);
            *(f32x4*)(mod + ((size_t)layer * NSEQ + row) * 6144 + c) = v + b; } )
    }
};
struct EpiZ {
    static constexpr bool PERM = true;
    bf16_t* zb; bf16_t* gb; float* out; int layer;
    __device__ __forceinline__ void operator()(const AccT& acc, const Unit& u, int wr, int wc, int fr, int fq) const {
        EPI_LOOP_PERM(
            if (col0 < ZC) { *(u32x4*)(zb + (size_t)row * ZC + col0) = pack8(v0, v1);
                if (col0 >= 256 && col0 < 1920) { const bool last = row < TP ? ((row & 2047) == 2047) : ((row & 3) == 3);
                    if (last) { float* o = row < TP ? out + O_SHP + (size_t)(layer * 8 + (row >> 11)) * RWC : out + O_SHS + (size_t)(layer * 128 + ((row - TP) >> 2)) * RWC;
                        *(f32x4*)(o + col0 - 256) = v0; *(f32x4*)(o + col0 - 252) = v1; } } }
            else if (col0 < INC) { f32x4 s0, s1;
                _Pragma("unroll") for (int j = 0; j < 4; ++j) { s0[j] = fsigmoid(v0[j]); s1[j] = fsigmoid(v1[j]); }
                *(u32x4*)(gb + (size_t)row * GC + (col0 - ZC)) = pack8(s0, s1); } )
    }
};
struct EpiGlu {
    static constexpr bool PERM = true;
    const bf16_t* ypre; bf16_t* yabc; const float* bglu;
    __device__ __forceinline__ void operator()(const AccT& acc, const Unit& u, int wr, int wc, int fr, int fq) const {
#pragma unroll
        for (int bj = 0; bj < 2; ++bj) { const int col0 = u.pn * 256 + bj * 128 + wc * 32 + 8 * fq;
            const f32x4 b0 = *(const f32x4*)(bglu + col0), b1 = *(const f32x4*)(bglu + col0 + 4);
#pragma unroll
            for (int ai = 0; ai < 2; ++ai)
#pragma unroll
                for (int m = 0; m < 4; ++m) { const int row = u.pm * 256 + ai * 128 + wr * 64 + m * 16 + fr;
                    const f32x4 v0 = acc[ai][bj][m][0] + b0, v1 = acc[ai][bj][m][1] + b1;
                    const u32x4 y = *(const u32x4*)(ypre + (size_t)row * 256 + col0);
                    f32x4 o0, o1;
                    o0[0] = bflo(y.x) * fsigmoid(v0[0]); o0[1] = bfhi(y.x) * fsigmoid(v0[1]); o0[2] = bflo(y.y) * fsigmoid(v0[2]); o0[3] = bfhi(y.y) * fsigmoid(v0[3]);
                    o1[0] = bflo(y.z) * fsigmoid(v1[0]); o1[1] = bfhi(y.z) * fsigmoid(v1[1]); o1[2] = bflo(y.w) * fsigmoid(v1[2]); o1[3] = bfhi(y.w) * fsigmoid(v1[3]);
                    *(u32x4*)(yabc + (size_t)row * 1024 + col0) = pack8(o0, o1);
                    asm volatile("" ::: "memory"); } }
    }
};
struct EpiLift {
    static constexpr bool PERM = true;
    bf16_t* gb; int j;
    __device__ __forceinline__ void operator()(const AccT& acc, const Unit& u, int wr, int wc, int fr, int fq) const {
        EPI_LOOP_PERM( bf16_t* pg = gb + (size_t)row * GC + j * 1024 + col0; bf16_t* pd = gb + (size_t)row * GC + col0; const u32x4 g = *(const u32x4*)pg; f32x4 o0, o1;
            o0[0] = bflo(g.x) * v0[0]; o0[1] = bfhi(g.x) * v0[1]; o0[2] = bflo(g.y) * v0[2]; o0[3] = bfhi(g.y) * v0[3];
            o1[0] = bflo(g.z) * v1[0]; o1[1] = bfhi(g.z) * v1[1]; o1[2] = bflo(g.w) * v1[2]; o1[3] = bfhi(g.w) * v1[3];
            if (j > 0) { const u32x4 d = *(const u32x4*)pd;
                o0[0] += bflo(d.x); o0[1] += bfhi(d.x); o0[2] += bflo(d.y); o0[3] += bfhi(d.y); o1[0] += bflo(d.z); o1[1] += bfhi(d.z); o1[2] += bflo(d.w); o1[3] += bfhi(d.w); }
            *(u32x4*)pd = pack8(o0, o1); )
    }
};
struct EpiRes {
    static constexpr bool PERM = false;
    float* hres; const float* gate;
    __device__ __forceinline__ void operator()(const AccT& acc, const Unit& u, int wr, int wc, int fr, int fq) const {
        EPI_LOOP_NOPERM( const f32x4 g = *(const f32x4*)(gate + (size_t)row2seq(row) * 6144 + col0); float* p = hres + (size_t)row * 1024 + col0; *(f32x4*)p = *(const f32x4*)p + g * v; )
    }
};
struct EpiUp {
    static constexpr bool PERM = true;
    bf16_t* up; bf16_t* halo; float* out; int layer;
    __device__ __forceinline__ void operator()(const AccT& acc, const Unit& u, int wr, int wc, int fr, int fq) const {
        EPI_LOOP_PERM( const u32x4 w = pack8(v0, v1); *(u32x4*)(up + (size_t)row * FF2 + col0) = w;
            const int r = row & 255; if (r >= 254) *(u32x4*)(halo + ((size_t)(row >> 8) * 2 + (r - 254)) * FF2 + col0) = w;
            const int tl = row < TP ? (row & 2047) - 2046 : (row & 3) - 2;
            if (tl >= 0) { float* o = row < TP ? out + O_CVP + ((size_t)(layer * 8 + (row >> 11)) * 2 + tl) * FF2 : out + O_CVS + ((size_t)(layer * 128 + ((row - TP) >> 2)) * 2 + tl) * FF2;
                *(f32x4*)(o + col0) = v0; *(f32x4*)(o + col0 + 4) = v1; } )
    }
};

struct Ctx { int tid, lane, wave, b, G; unsigned char* lds; };

template <class Epi>
__device__ __forceinline__ void run_gemm(const Ctx& c, const bf16_t* A, int lda, const bf16_t* Bt, int M, int N, int K, const Epi& E) {
    pg8::Gemm g; g.A = A; g.Bt = Bt; g.M = M; g.N = N; g.K = K; g.lda = lda;
    pg8::StaticOrder S; S.init(M, N, c.G, c.b);
    pg8::gemm_phase<Epi>((LAS unsigned char*)c.lds, g, S, E, c.tid);
}

__device__ __forceinline__ void transpose_item(const float* W, int N, bf16_t* WT, int ldk, int koff, int nrep, float* scr, int item, int lane) {
    const int nblk = N / 32, kb = item / nblk, nb = item % nblk, k0 = 64 * kb, n0 = 32 * nb;
#pragma unroll
    for (int i = 0; i < 8; ++i) { const int kk = 8 * i + (lane >> 3), cq = 4 * (lane & 7);
        const f32x4 w = *(const f32x4*)(W + (size_t)(k0 + kk) * N + n0 + cq);
        scr[kk * 33 + cq] = w[0]; scr[kk * 33 + cq + 1] = w[1]; scr[kk * 33 + cq + 2] = w[2]; scr[kk * 33 + cq + 3] = w[3]; }
    LDS_FENCE();
    const int cc = lane & 7;
#pragma unroll
    for (int j = 0; j < 4; ++j) { const int n = (lane >> 3) + 8 * j; const float* s = scr + (8 * cc) * 33 + n;
        u32x4 o; o.x = cvt_pk_bf16(s[0 * 33], s[1 * 33]); o.y = cvt_pk_bf16(s[2 * 33], s[3 * 33]); o.z = cvt_pk_bf16(s[4 * 33], s[5 * 33]); o.w = cvt_pk_bf16(s[6 * 33], s[7 * 33]);
        for (int r = 0; r < nrep; ++r) *(u32x4*)(WT + (size_t)(n0 + n) * ldk + koff + r * 1024 + k0 + 8 * cc) = o; }
    LDS_FENCE();
}
struct TJob { const float* W; int K, N; bf16_t* WT; int ldk, nrep; };
__device__ __forceinline__ void convert_jobs(const Ctx& c, const TJob* jobs, int njobs) {
    float* scr = (float*)(c.lds) + c.wave * (64 * 33);
    const int gw = c.b * NWAVES + c.wave, NGW = c.G * NWAVES;
    int base = 0;
    for (int j = 0; j < njobs; ++j) {
        const int items = (jobs[j].K / 64) * (jobs[j].N / 32);
        int first = (gw - (base % NGW) + NGW) % NGW;
        for (int it = first; it < items; it += NGW) transpose_item(jobs[j].W, jobs[j].N, jobs[j].WT, jobs[j].ldk, 0, jobs[j].nrep, scr, it, c.lane);
        base += items;
    }
}
__device__ __forceinline__ void convert_layer_weights(PRef P, const Ctx& c, int layer, int which = 0) {
    unsigned char* ws = P.ws;
    TJob jobs[8];
    jobs[0] = TJob{P.in[I_WIN] + (size_t)layer * 1024 * INC, 1024, INC, (bf16_t*)(ws + WS_WIN), 1024, 1};
    jobs[1] = TJob{P.in[I_WUP] + (size_t)layer * 1024 * FF2, 1024, FF2, (bf16_t*)(ws + WS_WUP), 1024, 1};
    jobs[2] = TJob{P.in[I_WDN] + (size_t)layer * FF * 1024, FF, 1024, (bf16_t*)(ws + WS_WDN), FF, 1};
    jobs[3] = TJob{P.in[I_WOUT] + (size_t)layer * 1024 * 1024, 1024, 1024, (bf16_t*)(ws + WS_WOUT3), 1024, 1};
    jobs[4] = TJob{P.in[I_LFB] + (size_t)layer * 512 * 1024, 512, 1024, (bf16_t*)(ws + WS_LB), 512, 1};
    jobs[5] = TJob{P.in[I_LFA] + (size_t)layer * 256 * 1024, 256, 1024, (bf16_t*)(ws + WS_LA), 256, 1};
    jobs[6] = TJob{P.in[I_LFC] + (size_t)layer * 256 * 1024, 256, 1024, (bf16_t*)(ws + WS_LC), 256, 1};
    jobs[7] = TJob{P.in[I_WGLU] + (size_t)layer * 256 * 256, 256, 256, (bf16_t*)(ws + WS_WGLU), 256, 1};
#pragma unroll
    for (int j = 0; j < 8; ++j) { if ((which == 1 && j != 0) || (which == 2 && j == 0)) continue; TJob one = jobs[j]; convert_jobs(c, &one, 1); }
}

__device__ __forceinline__ void phase_start(PRef P, const Ctx& c) {
    unsigned char* ws = P.ws;
    for (int l = 0; l < 2; ++l) { TJob one{P.in[I_WADA] + (size_t)l * 1024 * 6144, 1024, 6144, (bf16_t*)(ws + WS_WADA) + (size_t)l * 6144 * 1024, 1024, 1}; convert_jobs(c, &one, 1); }
    convert_layer_weights(P, c, 0, c.G == 256 ? 1 : 0);
    bf16_t* aada = (bf16_t*)(ws + WS_AADA);
    for (int i = c.b * NTHREADS + c.tid; i < 256 * 1024; i += c.G * NTHREADS) {
        const int r = i >> 10, k = i & 1023; float v = 0.f;
        if (r < NSEQ) { const float x = r < 8 ? P.in[I_CP][r * 1024 + k] : P.in[I_CS][(r - 8) * 1024 + k]; v = x * fsigmoid(x); }
        aada[i] = f2bf(v);
    }
}

__device__ __forceinline__ void phase_norm(PRef P, const Ctx& c, int layer, int which, bool first) {
    const float* mod = (const float*)(P.ws + WS_MOD) + (size_t)layer * NSEQ * 6144;
    const float* gw_ = P.in[which ? I_GFFN : I_GMIX] + layer * 1024;
    bf16_t* H = (bf16_t*)(P.ws + WS_H);
    const int gw = c.b * NWAVES + c.wave, NGW = c.G * NWAVES;
    for (int row = gw; row < T; row += NGW) {
        const float* src = first ? (row < TP ? P.in[I_XP] + (size_t)row * 1024 : P.in[I_XS] + (size_t)(row - TP) * 1024) : P.out + (size_t)row * 1024;
        const float* m = mod + (size_t)row2seq(row) * 6144 + (which ? 3 : 0) * 1024;
        f32x4 v[4]; float ss = 0.f;
#pragma unroll
        for (int j = 0; j < 4; ++j) { v[j] = *(const f32x4*)(src + 256 * j + 4 * c.lane); ss += (v[j][0] * v[j][0] + v[j][1] * v[j][1]) + (v[j][2] * v[j][2] + v[j][3] * v[j][3]); }
        const float rstd = rsqrtf(wave_sum(ss) * (1.f / 1024.f) + 1e-6f);
#pragma unroll
        for (int j = 0; j < 4; ++j) { const int col = 256 * j + 4 * c.lane;
            const f32x4 g = *(const f32x4*)(gw_ + col), sh = *(const f32x4*)(m + col), sc = *(const f32x4*)(m + 1024 + col);
            if (first) *(f32x4*)(P.out + (size_t)row * 1024 + col) = v[j];
            f32x4 h;
#pragma unroll
            for (int e = 0; e < 4; ++e) h[e] = v[j][e] * rstd * g[e] * (1.f + sc[e]) + sh[e];
            u32x2 w; w.x = cvt_pk_bf16(h[0], h[1]); w.y = cvt_pk_bf16(h[2], h[3]);
            *(u32x2*)(H + (size_t)row * 1024 + col) = w; }
    }
}
__device__ __forceinline__ void phase_final_norm(PRef P, const Ctx& c) {
    const float* fg = P.in[I_FG];
    const int gw = c.b * NWAVES + c.wave, NGW = c.G * NWAVES;
    for (int row = gw; row < T; row += NGW) {
        float* src = P.out + (size_t)row * 1024;
        f32x4 v[4]; float ss = 0.f;
#pragma unroll
        for (int j = 0; j < 4; ++j) { v[j] = *(const f32x4*)(src + 256 * j + 4 * c.lane); ss += (v[j][0] * v[j][0] + v[j][1] * v[j][1]) + (v[j][2] * v[j][2] + v[j][3] * v[j][3]); }
        const float rstd = rsqrtf(wave_sum(ss) * (1.f / 1024.f) + 1e-6f);
#pragma unroll
        for (int j = 0; j < 4; ++j) { const int col = 256 * j + 4 * c.lane; const f32x4 g = *(const f32x4*)(fg + col); *(f32x4*)(src + col) = v[j] * rstd * g; }
    }
}

struct SeqInfo { int n, L, row0; bool prompt; };
__device__ __forceinline__ SeqInfo seq_info(int s) { SeqInfo q; q.prompt = s < 8; q.n = q.prompt ? s : s - 8; q.L = q.prompt ? 2048 : 4; q.row0 = q.prompt ? s * 2048 : TP + (s - 8) * 4; return q; }

__device__ __forceinline__ void rwkv_prefetch(const bf16_t* zb, const SeqInfo& q, int h, int t0, int tid, u32x4 (&pre)[3]) {
    const int len = (q.L - t0) < 32 ? (q.L - t0) : 32;
#pragma unroll
    for (int it = 0; it < 3; ++it) { const int idx = tid + it * NTHREADS; pre[it] = (u32x4){0u, 0u, 0u, 0u};
        if (idx < 33 * 40 && t0 < q.L) { const int rr = idx / 40, vec = idx - rr * 40; const int pc = vec < 24 ? (vec >> 3) * 512 + h * 64 + (vec & 7) * 8 : 1536 + (vec - 24) * 8; const int tg = t0 - 1 + rr;
            if (tg >= 0 && rr <= len) pre[it] = *(const u32x4*)(zb + ((size_t)q.row0 + tg) * ZC + 256 + pc); } }
}
__device__ __forceinline__ void rwkv_unit(PRef P, const Ctx& c, int layer, int s, int h) {
    const SeqInfo q = seq_info(s);
    const bf16_t* zb = (const bf16_t*)(P.ws + WS_Z);
    bf16_t* yabc = (bf16_t*)(P.ws + WS_H);
    float* sm = (float*)c.lds;
    float* XR = sm; float* XK = sm + 2048; float* XV = sm + 4096; float* DEC = sm + 6144; float* AIC = sm + 8192; float* GG = sm + 10240; float* KKn = sm + 12288; float* YO = sm + 14336;
    float* BON = sm + 16384;
    bf16_t* LW = (bf16_t*)(sm + 16448);
    bf16_t* LA = LW + 1024;
    bf16_t* LG = LA + 1024;
    float* RAW = sm + 18496;
    float* MU = sm + 29056;
    const int tid = c.tid, lane = c.lane, wave = c.wave;
    const float* mu = P.in[I_MU] + layer * RWC;
    const float* shiftst = q.prompt ? nullptr : P.in[I_SSH] + ((size_t)layer * 128 + q.n) * RWC;
    const int mt = wave >> 2, ntile = wave & 3, quad = lane >> 4, l15 = lane & 15;
    const int cB = h * 64 + ntile * 16 + l15;
    bf16x8 bW, bA, bG0, bG1;
    {
        const float* w2 = P.in[I_W2] + (size_t)layer * 32 * 512; const float* a2 = P.in[I_A2] + (size_t)layer * 32 * 512; const float* g2 = P.in[I_G2] + (size_t)layer * 64 * 512;
#pragma unroll
        for (int j = 0; j < 8; ++j) { bW[j] = (short)f2bf(w2[(quad * 8 + j) * 512 + cB]); bA[j] = (short)f2bf(a2[(quad * 8 + j) * 512 + cB]);
            bG0[j] = (short)f2bf(g2[(quad * 8 + j) * 512 + cB]); bG1[j] = (short)f2bf(g2[(32 + quad * 8 + j) * 512 + cB]); }
    }
    const float w0c = P.in[I_W0][layer * 512 + cB], a0c = P.in[I_A0][layer * 512 + cB];
    const int cl = h * 64 + lane;
    const float kkc = P.in[I_KK][layer * 512 + cl], kac = P.in[I_KA][layer * 512 + cl], rkc = P.in[I_RK][layer * 512 + cl], lnw = P.in[I_LNW][layer * 512 + cl], lnb = P.in[I_LNB][layer * 512 + cl];
    const int v = tid >> 3, sub = tid & 7;
    float st[8];
    if (q.prompt) {
#pragma unroll
        for (int j = 0; j < 8; ++j) st[j] = 0.f;
    } else {
        const float* sp = P.in[I_SRW] + (((size_t)layer * 128 + q.n) * 8 + h) * 4096 + v * 64 + sub * 8;
        const f32x4 a = *(const f32x4*)sp, b = *(const f32x4*)(sp + 4);
        st[0] = a[0]; st[1] = a[1]; st[2] = a[2]; st[3] = a[3]; st[4] = b[0]; st[5] = b[1]; st[6] = b[2]; st[7] = b[3];
    }
    u32x4 pre[3]; rwkv_prefetch(zb, q, h, 0, tid, pre);
    if (tid < 320) { const int pcm = tid < 192 ? (tid >> 6) * 512 + h * 64 + (tid & 63) : 1536 + (tid - 192); MU[tid] = mu[pcm]; }
    for (int t0 = 0; t0 < q.L; t0 += 32) {
        const int len = (q.L - t0) < 32 ? (q.L - t0) : 32;
#pragma unroll
        for (int it = 0; it < 3; ++it) { const int idx = tid + it * NTHREADS;
            if (idx < 33 * 40) {
                const int rr = idx / 40, vec = idx - rr * 40;
                const int pc = vec < 24 ? (vec >> 3) * 512 + h * 64 + (vec & 7) * 8 : 1536 + (vec - 24) * 8;
                const int tg = t0 - 1 + rr;
                f32x4 x0 = {0.f, 0.f, 0.f, 0.f}, x1 = x0;
                if (tg < 0) { if (!q.prompt) { x0 = *(const f32x4*)(shiftst + pc); x1 = *(const f32x4*)(shiftst + pc + 4); } }
                else if (rr <= len) { const u32x4 w = pre[it];
                    x0 = (f32x4){bflo(w.x), bfhi(w.x), bflo(w.y), bfhi(w.y)}; x1 = (f32x4){bflo(w.z), bfhi(w.z), bflo(w.w), bfhi(w.w)}; }
                *(f32x4*)(RAW + rr * 320 + vec * 8) = x0; *(f32x4*)(RAW + rr * 320 + vec * 8 + 4) = x1; } }
        __syncthreads();
        for (int idx = tid; idx < 32 * 48; idx += NTHREADS) {
            const int t = idx / 48, cc = (idx - t * 48) * 4;
            f32x4 xm = {0.f, 0.f, 0.f, 0.f};
            if (t < len) { const f32x4 p = *(const f32x4*)(RAW + (t + 1) * 320 + cc), pp = *(const f32x4*)(RAW + t * 320 + cc), m = *(const f32x4*)(MU + cc); xm = p + (pp - p) * m; }
            float* dst = cc < 64 ? XR + t * 64 + cc : cc < 128 ? XK + t * 64 + cc - 64 : XV + t * 64 + cc - 128;
            *(f32x4*)dst = xm;
        }
        for (int idx = tid; idx < 32 * 128; idx += NTHREADS) {
            const int t = idx >> 7, j = idx & 127, cc = 192 + j;
            float x = 0.f;
            if (t < len) { const float p = RAW[(t + 1) * 320 + cc], pp = RAW[t * 320 + cc]; x = p + (pp - p) * MU[cc]; }
            const float sg = fsigmoid(j < 32 ? 2.f * x : x);
            const float val = j < 32 ? 2.f * sg - 1.f : (j < 64 ? x : sg);
            bf16_t* dst = j < 32 ? LW + t * 32 + j : (j < 64 ? LA + t * 32 + j - 32 : LG + t * 64 + j - 64);
            *dst = f2bf(val);
        }
        __syncthreads();
        {
            const bf16x8 aW = *(const bf16x8*)(LW + (mt * 16 + l15) * 32 + quad * 8), aA = *(const bf16x8*)(LA + (mt * 16 + l15) * 32 + quad * 8);
            const bf16x8 aG0 = *(const bf16x8*)(LG + (mt * 16 + l15) * 64 + quad * 8), aG1 = *(const bf16x8*)(LG + (mt * 16 + l15) * 64 + 32 + quad * 8);
            const f32x4 z4 = {0.f, 0.f, 0.f, 0.f};
            f32x4 cw = __builtin_amdgcn_mfma_f32_16x16x32_bf16(aW, bW, z4, 0, 0, 0);
            f32x4 ca = __builtin_amdgcn_mfma_f32_16x16x32_bf16(aA, bA, z4, 0, 0, 0);
            f32x4 cg_ = __builtin_amdgcn_mfma_f32_16x16x32_bf16(aG0, bG0, z4, 0, 0, 0);
            cg_ = __builtin_amdgcn_mfma_f32_16x16x32_bf16(aG1, bG1, cg_, 0, 0, 0);
#pragma unroll
            for (int j = 0; j < 4; ++j) { const int t = mt * 16 + quad * 4 + j, cc = ntile * 16 + l15;
                const float wv = w0c + cw[j]; const float nx = -wv; const float sp = (nx > 0.f ? nx : 0.f) + __logf(1.f + __expf(-fabsf(nx)));
                DEC[t * 64 + cc] = __expf(-__expf(-sp - 0.5f));
                AIC[t * 64 + cc] = fsigmoid(a0c + ca[j]);
                GG[t * 64 + cc] = cg_[j]; }
        }
        __syncthreads();
#pragma unroll
        for (int i = 0; i < 4; ++i) { const int t = wave + 8 * i; const int o = t * 64 + lane;
            const float k = XK[o], a = AIC[o], r = XR[o];
            const float kkv = k * kkc; const float ssq = wave_sum(kkv * kkv); const float kk = kkv * rsqrtf(fmaxf(ssq, 1e-24f));
            const float kp = k * (1.f + (a - 1.f) * kac);
            const float bon = wave_sum(r * kp * rkc);
            XK[o] = kp; KKn[o] = kk; AIC[o] = kk * a; if (lane == 0) BON[t] = bon; }
        __syncthreads();
        rwkv_prefetch(zb, q, h, t0 + 32, tid, pre);
        {
            f32x2v s2[4] = {{st[0], st[1]}, {st[2], st[3]}, {st[4], st[5]}, {st[6], st[7]}};
            for (int t = 0; t < len; ++t) {
                const int o = t * 64 + sub * 8;
                const f32x4 r0 = *(const f32x4*)(XR + o), r1 = *(const f32x4*)(XR + o + 4), w0 = *(const f32x4*)(DEC + o), w1 = *(const f32x4*)(DEC + o + 4), k0 = *(const f32x4*)(XK + o), k1 = *(const f32x4*)(XK + o + 4);
                const f32x4 n0 = *(const f32x4*)(KKn + o), n1 = *(const f32x4*)(KKn + o + 4), b0 = *(const f32x4*)(AIC + o), b1 = *(const f32x4*)(AIC + o + 4);
                const float vv = XV[t * 64 + v];
                f32x2v acc = s2[0] * n0.xy; acc = s2[1] * n0.zw + acc; acc = s2[2] * n1.xy + acc; acc = s2[3] * n1.zw + acc;
                const float sa = -red8(acc.x + acc.y);
                const f32x2v sa2 = {sa, sa}, vv2 = {vv, vv};
                s2[0] = s2[0] * w0.xy + (sa2 * b0.xy + vv2 * k0.xy); s2[1] = s2[1] * w0.zw + (sa2 * b0.zw + vv2 * k0.zw);
                s2[2] = s2[2] * w1.xy + (sa2 * b1.xy + vv2 * k1.xy); s2[3] = s2[3] * w1.zw + (sa2 * b1.zw + vv2 * k1.zw);
                f32x2v ya = s2[0] * r0.xy; ya = s2[1] * r0.zw + ya; ya = s2[2] * r1.xy + ya; ya = s2[3] * r1.zw + ya;
                const float y = red8(ya.x + ya.y);
                if (sub == 0) YO[t * 64 + v] = y;
            }
            st[0] = s2[0].x; st[1] = s2[0].y; st[2] = s2[1].x; st[3] = s2[1].y; st[4] = s2[2].x; st[5] = s2[2].y; st[6] = s2[3].x; st[7] = s2[3].y;
        }
        __syncthreads();
#pragma unroll
        for (int i = 0; i < 4; ++i) { const int t = wave + 8 * i; if (t < len) { const int o = t * 64 + lane;
            const float y = YO[o]; const float mean = wave_sum(y) * (1.f / 64.f); const float d = y - mean; const float var = wave_sum(d * d) * (1.f / 64.f);
            const float yn = d * rsqrtf(var + 64e-5f);
            const float res = (yn * lnw + lnb + BON[t] * XV[o]) * GG[o];
            yabc[((size_t)q.row0 + t0 + t) * 1024 + 256 + h * 64 + lane] = f2bf(res); } }
        __syncthreads();
    }
    float* so = q.prompt ? P.out + O_RWP + (((size_t)layer * 8 + q.n) * 8 + h) * 4096 : P.out + O_RWS + (((size_t)layer * 128 + q.n) * 8 + h) * 4096;
    *(f32x4*)(so + v * 64 + sub * 8) = (f32x4){st[0], st[1], st[2], st[3]}; *(f32x4*)(so + v * 64 + sub * 8 + 4) = (f32x4){st[4], st[5], st[6], st[7]};
}

__device__ __forceinline__ void hgrn_unit(PRef P, const Ctx& c, int layer, int s, int h) {
    const SeqInfo q = seq_info(s);
    const bf16_t* zb = (const bf16_t*)(P.ws + WS_Z);
    bf16_t* yabc = (bf16_t*)(P.ws + WS_H);
    float* sm = (float*)c.lds;
    float* FQ = sm; float* FFg = sm + 2048; float* FK = sm + 4096; float* FI = sm + 6144; float* FO = sm + 8192; float* OO = sm + 10240;
    const int tid = c.tid, lane = c.lane, wave = c.wave;
    const int vc = tid >> 3, sub = tid & 7;
    float st[8];
    if (q.prompt) {
#pragma unroll
        for (int j = 0; j < 8; ++j) st[j] = 0.f;
    } else {
        const float* sp = P.in[I_SHG] + (((size_t)layer * 128 + q.n) * 4 + h) * 4096;
#pragma unroll
        for (int j = 0; j < 8; ++j) st[j] = sp[(sub * 8 + j) * 64 + vc];
    }
    const float hn = P.in[I_HNORM][layer * 256 + h * 64 + lane];
    for (int t0 = 0; t0 < q.L; t0 += 32) {
        const int len = (q.L - t0) < 32 ? (q.L - t0) : 32;
        for (int idx = tid; idx < 1024; idx += NTHREADS) {
            const int t = idx >> 5, arr = (idx >> 3) & 3, vec = idx & 7; const int c0 = vec * 8;
            float xv[8];
            if (t < len) { const u32x4 w = *(const u32x4*)(zb + ((size_t)q.row0 + t0 + t) * ZC + 1920 + arr * 256 + h * 64 + c0);
                xv[0] = bflo(w.x); xv[1] = bfhi(w.x); xv[2] = bflo(w.y); xv[3] = bfhi(w.y); xv[4] = bflo(w.z); xv[5] = bfhi(w.z); xv[6] = bflo(w.w); xv[7] = bfhi(w.w); }
            else {
#pragma unroll
                for (int j = 0; j < 8; ++j) xv[j] = 0.f; }
            const int o = t * 64 + c0;
            if (arr == 0) {
#pragma unroll
                for (int j = 0; j < 8; ++j) FQ[o + j] = xv[j] * fsigmoid(xv[j]); }
            else if (arr == 1) {
#pragma unroll
                for (int j = 0; j < 8; ++j) { float lower = 0.f;
                    if (layer == 1) { const float l0 = P.in[I_HLB][h * 64 + c0 + j], l1 = P.in[I_HLB][256 + h * 64 + c0 + j]; lower = fsigmoid(l1 - l0); }
                    const float fg = lower + (1.f - lower) * fsigmoid(xv[j]);
                    FFg[o + j] = fmaxf(fg, 1e-30f); FK[o + j] = 1.f - fg; } }
            else if (arr == 2) {
#pragma unroll
                for (int j = 0; j < 8; ++j) FI[o + j] = xv[j]; }
            else {
#pragma unroll
                for (int j = 0; j < 8; ++j) FO[o + j] = fsigmoid(xv[j]); }
        }
        __syncthreads();
        {
            f32x2v s2[4] = {{st[0], st[1]}, {st[2], st[3]}, {st[4], st[5]}, {st[6], st[7]}};
            for (int t = 0; t < len; ++t) {
                const int o8 = t * 64 + sub * 8;
                const f32x4 q0 = *(const f32x4*)(FQ + o8), q1 = *(const f32x4*)(FQ + o8 + 4), f0 = *(const f32x4*)(FFg + o8), f1 = *(const f32x4*)(FFg + o8 + 4), k0 = *(const f32x4*)(FK + o8), k1 = *(const f32x4*)(FK + o8 + 4);
                const float iv = FI[t * 64 + vc]; const f32x2v iv2 = {iv, iv};
                s2[0] = f0.xy * s2[0] + k0.xy * iv2; s2[1] = f0.zw * s2[1] + k0.zw * iv2; s2[2] = f1.xy * s2[2] + k1.xy * iv2; s2[3] = f1.zw * s2[3] + k1.zw * iv2;
                f32x2v oa = s2[0] * q0.xy; oa = s2[1] * q0.zw + oa; oa = s2[2] * q1.xy + oa; oa = s2[3] * q1.zw + oa;
                const float o = red8(oa.x + oa.y);
                if (sub == 0) OO[t * 64 + vc] = o;
            }
            st[0] = s2[0].x; st[1] = s2[0].y; st[2] = s2[1].x; st[3] = s2[1].y; st[4] = s2[2].x; st[5] = s2[2].y; st[6] = s2[3].x; st[7] = s2[3].y;
        }
        __syncthreads();
#pragma unroll
        for (int i = 0; i < 4; ++i) { const int t = wave + 8 * i; if (t < len) { const int o = t * 64 + lane;
            const float ov = OO[o]; const float ms = wave_sum(ov * ov) * (1.f / 64.f);
            yabc[((size_t)q.row0 + t0 + t) * 1024 + 768 + h * 64 + lane] = f2bf(ov * rsqrtf(ms + 1e-6f) * hn * FO[o]); } }
        __syncthreads();
    }
    float* so = q.prompt ? P.out + O_HGP + (((size_t)layer * 8 + q.n) * 4 + h) * 4096 : P.out + O_HGS + (((size_t)layer * 128 + q.n) * 4 + h) * 4096;
#pragma unroll
    for (int j = 0; j < 8; ++j) so[(sub * 8 + j) * 64 + vc] = st[j];
}

struct S5Const { float bbr[16], bbi[16], cm[32], ar, ai, dsk; };
__device__ __forceinline__ void s5_const(PRef P, int layer, int g, int lane, S5Const& k) {
    const int p = lane;
    const float lr = P.in[I_LRE][(layer * 16 + g) * 64 + p], li = P.in[I_LIM][(layer * 16 + g) * 64 + p];
    const float dt = expf(P.in[I_LDT][layer * 16 + g]);
    const float mag = expf(lr * dt); const float ar = mag * cosf(li * dt), ai = mag * sinf(li * dt);
    const float den = lr * lr + li * li;
    const float zr = ((ar - 1.f) * lr + ai * li) / den, zi = (ai * lr - (ar - 1.f) * li) / den;
    const float* bre = P.in[I_BRE] + ((size_t)(layer * 16 + g) * 64 + p) * 16; const float* bim = P.in[I_BIM] + ((size_t)(layer * 16 + g) * 64 + p) * 16;
#pragma unroll
    for (int cc = 0; cc < 16; ++cc) { const float br = bre[cc], bi = bim[cc]; k.bbr[cc] = zr * br - zi * bi; k.bbi[cc] = zr * bi + zi * br; }
    const int cch = lane & 15, quad = lane >> 4;
    const float* cre = P.in[I_CRE] + ((size_t)(layer * 16 + g) * 16 + cch) * 64; const float* cim = P.in[I_CIM] + ((size_t)(layer * 16 + g) * 16 + cch) * 64;
#pragma unroll
    for (int kk = 0; kk < 32; ++kk) { const int qq = 4 * kk + quad; k.cm[kk] = qq < 64 ? cre[qq] : -cim[qq - 64]; }
    k.ar = ar; k.ai = ai; k.dsk = P.in[I_S5D][layer * 256 + g * 16 + cch];
}
template <bool FULL>
__device__ __forceinline__ void s5_chunk(PRef P, const S5Const& k, int g, int rowbase, int len, float& sr, float& si, float* wscr, int lane) {
    const bf16_t* zb = (const bf16_t*)(P.ws + WS_Z);
    bf16_t* ypre = (bf16_t*)(P.ws + WS_YPRE);
    float* U = wscr; float* Sm = wscr + 1024;
    LDS_FENCE();
    if (lane < len) { const u32x4 a = *(const u32x4*)(zb + (size_t)(rowbase + lane) * ZC + g * 16), b = *(const u32x4*)(zb + (size_t)(rowbase + lane) * ZC + g * 16 + 8);
        float* up = U + lane * 16;
        *(f32x4*)(up) = (f32x4){bflo(a.x), bfhi(a.x), bflo(a.y), bfhi(a.y)}; *(f32x4*)(up + 4) = (f32x4){bflo(a.z), bfhi(a.z), bflo(a.w), bfhi(a.w)};
        *(f32x4*)(up + 8) = (f32x4){bflo(b.x), bfhi(b.x), bflo(b.y), bfhi(b.y)}; *(f32x4*)(up + 12) = (f32x4){bflo(b.z), bfhi(b.z), bflo(b.w), bfhi(b.w)}; }
    LDS_FENCE();
    const int nsub = (len + 15) >> 4;
    for (int sb = 0; sb < nsub; ++sb) {
#pragma unroll 4
        for (int tt = 0; tt < 16; ++tt) {
            const int t = sb * 16 + tt;
            if (t < len) {
                const f32x4* up = (const f32x4*)(U + t * 16); const f32x4 u0 = up[0], u1 = up[1], u2 = up[2], u3 = up[3];
                float er = 0.f, ei = 0.f;
#pragma unroll
                for (int j = 0; j < 4; ++j) { er += k.bbr[j] * u0[j]; ei += k.bbi[j] * u0[j]; }
#pragma unroll
                for (int j = 0; j < 4; ++j) { er += k.bbr[4 + j] * u1[j]; ei += k.bbi[4 + j] * u1[j]; }
#pragma unroll
                for (int j = 0; j < 4; ++j) { er += k.bbr[8 + j] * u2[j]; ei += k.bbi[8 + j] * u2[j]; }
#pragma unroll
                for (int j = 0; j < 4; ++j) { er += k.bbr[12 + j] * u3[j]; ei += k.bbi[12 + j] * u3[j]; }
                const float nr = k.ar * sr - k.ai * si + er, ni = k.ar * si + k.ai * sr + ei;
                sr = nr; si = ni;
                if (FULL) { Sm[tt * 132 + lane] = sr; Sm[tt * 132 + 64 + lane] = si; }
            } else if (FULL) { Sm[tt * 132 + lane] = 0.f; Sm[tt * 132 + 64 + lane] = 0.f; }
        }
        if (FULL) {
            LDS_FENCE();
            const int row = lane & 15, quad = lane >> 4;
            f32x4 acc = {0.f, 0.f, 0.f, 0.f};
#pragma unroll
            for (int kk = 0; kk < 32; ++kk) acc = __builtin_amdgcn_mfma_f32_16x16x4f32(Sm[row * 132 + 4 * kk + quad], k.cm[kk], acc, 0, 0, 0);
#pragma unroll
            for (int j = 0; j < 4; ++j) { const int t = sb * 16 + quad * 4 + j;
                if (t < len) { const float y = acc[j] + k.dsk * U[t * 16 + row]; ypre[(size_t)(rowbase + t) * 256 + g * 16 + row] = f2bf(gelu_tanh(y)); } }
            LDS_FENCE();
        }
    }
}
__device__ __forceinline__ void cmul_acc(float ar, float ai, float& sr, float& si, float er, float ei) { const float nr = ar * sr - ai * si + er, ni = ar * si + ai * sr + ei; sr = nr; si = ni; }
__device__ __forceinline__ void s5_prompt_unit(PRef P, const Ctx& c, int layer, int n, int g) {
    S5Const k; s5_const(P, layer, g, c.lane, k);
    float* sm = (float*)c.lds;
    float* END = sm;
    float* wscr = sm + 1024 + c.wave * (1024 + 16 * 132);
    float a64r = k.ar, a64i = k.ai;
#pragma unroll
    for (int i = 0; i < 6; ++i) { const float r = a64r * a64r - a64i * a64i; float im = a64r * a64i; im += im; a64r = r; a64i = im; }
    float cr = 0.f, ci = 0.f;
    for (int round = 0; round < 4; ++round) {
        const int rowbase = n * 2048 + (round * 8 + c.wave) * 64;
        float lr_ = 0.f, li_ = 0.f;
        s5_chunk<false>(P, k, g, rowbase, 64, lr_, li_, wscr, c.lane);
        END[c.wave * 128 + c.lane] = lr_; END[c.wave * 128 + 64 + c.lane] = li_;
        __syncthreads();
        float sr = cr, si = ci, ar_ = cr, ai_ = ci;
        for (int w = 0; w < 8; ++w) { const float er = END[w * 128 + c.lane], ei = END[w * 128 + 64 + c.lane];
            if (w < c.wave) cmul_acc(a64r, a64i, sr, si, er, ei);
            cmul_acc(a64r, a64i, ar_, ai_, er, ei); }
        cr = ar_; ci = ai_;
        __syncthreads();
        s5_chunk<true>(P, k, g, rowbase, 64, sr, si, wscr, c.lane);
    }
    if (c.wave == 0) { float* o = P.out + O_S5P + (((size_t)layer * 8 + n) * 16 + g) * 128 + c.lane * 2; o[0] = cr; o[1] = ci; }
    __syncthreads();
}
__device__ __forceinline__ void s5_sample_wave(PRef P, const Ctx& c, int layer, int n, int g) {
    S5Const k; s5_const(P, layer, g, c.lane, k);
    float* wscr = (float*)c.lds + 1024 + c.wave * (1024 + 16 * 132);
    const float* sp = P.in[I_SS5] + (((size_t)layer * 128 + n) * 16 + g) * 128 + c.lane * 2;
    float sr = sp[0], si = sp[1];
    s5_chunk<true>(P, k, g, TP + n * 4, 4, sr, si, wscr, c.lane);
    float* o = P.out + O_S5S + (((size_t)layer * 128 + n) * 16 + g) * 128 + c.lane * 2; o[0] = sr; o[1] = si;
}

__device__ __forceinline__ void phase_scan(PRef P, const Ctx& c, int layer) {
    for (int u = c.b; u < 224; u += c.G) {
        if (u < 64) rwkv_unit(P, c, layer, u >> 3, u & 7);
        else if (u < 96) hgrn_unit(P, c, layer, (u - 64) >> 2, (u - 64) & 3);
        else s5_prompt_unit(P, c, layer, (u - 96) >> 4, (u - 96) & 15);
    }
    if (c.G == 256 && c.b >= 224) { Ctx cc = c; cc.b = c.b - 224; cc.G = 32; convert_layer_weights(P, cc, layer, 2); __syncthreads(); }
    const int nb = c.G > 96 ? c.G - 96 : c.G, sb = c.G > 96 ? c.b - 96 : c.b;
    if (sb >= 0) for (int j = sb; j < 1792; j += nb) {
        if (j < 1024) rwkv_unit(P, c, layer, 8 + (j >> 3), j & 7);
        else if (j < 1536) hgrn_unit(P, c, layer, 8 + ((j - 1024) >> 2), (j - 1024) & 3);
        else { const int w = (j - 1536) * 8 + c.wave; s5_sample_wave(P, c, layer, w >> 4, w & 15); __syncthreads(); }
    }
}

__device__ __forceinline__ void unpack8(const u32x4 w, float* x) { x[0] = bflo(w.x); x[1] = bfhi(w.x); x[2] = bflo(w.y); x[3] = bfhi(w.y); x[4] = bflo(w.z); x[5] = bfhi(w.z); x[6] = bflo(w.w); x[7] = bfhi(w.w); }
__device__ __forceinline__ void phase_conv(PRef P, const Ctx& c, int layer) {
    bf16_t* up = (bf16_t*)(P.ws + WS_UP); const bf16_t* halo = (const bf16_t*)(P.ws + WS_HALO);
    const float* cw = P.in[I_CW] + (size_t)layer * 3 * FF2; const float* cb = P.in[I_CB] + (size_t)layer * FF2;
    const int cgp = c.tid & 31, seg = c.tid >> 5;
    for (int item = c.b; item < 66 * 11; item += c.G) {
        const int pm = item / 11, strip = item - pm * 11; const int c0 = strip * 256 + cgp * 8;
        const int r0 = pm * 256 + seg * 16;
        float wa[3][8], wb[3][8], ba[8], bb[8];
#pragma unroll
        for (int j = 0; j < 3; ++j)
#pragma unroll
            for (int e = 0; e < 8; ++e) { wa[j][e] = cw[j * FF2 + c0 + e]; wb[j][e] = cw[j * FF2 + FF + c0 + e]; }
#pragma unroll
        for (int e = 0; e < 8; ++e) { ba[e] = cb[c0 + e]; bb[e] = cb[FF + c0 + e]; }
        float p2a[8], p2b[8], p1a[8], p1b[8];
        {
            const int tl = r0 < TP ? (r0 & 2047) : ((r0 - TP) & 3);
            if (tl == 0) {
#pragma unroll
                for (int e = 0; e < 8; ++e) { p2a[e] = p2b[e] = p1a[e] = p1b[e] = 0.f; }
            } else {
                const bf16_t* s2 = seg > 0 ? up + (size_t)(r0 - 2) * FF2 : halo + ((size_t)(pm - 1) * 2 + 0) * FF2;
                const bf16_t* s1 = seg > 0 ? up + (size_t)(r0 - 1) * FF2 : halo + ((size_t)(pm - 1) * 2 + 1) * FF2;
                unpack8(*(const u32x4*)(s2 + c0), p2a); unpack8(*(const u32x4*)(s2 + FF + c0), p2b); unpack8(*(const u32x4*)(s1 + c0), p1a); unpack8(*(const u32x4*)(s1 + FF + c0), p1b);
            }
        }
        __syncthreads();
        for (int rb = 0; rb < 4; ++rb) {
            u32x4 ra[4], rbv[4];
#pragma unroll
            for (int i = 0; i < 4; ++i) { const size_t row = (size_t)r0 + rb * 4 + i; ra[i] = *(const u32x4*)(up + row * FF2 + c0); rbv[i] = *(const u32x4*)(up + row * FF2 + FF + c0); }
#pragma unroll
            for (int i = 0; i < 4; ++i) { const int row = r0 + rb * 4 + i;
                const int tl = row < TP ? (row & 2047) : ((row - TP) & 3);
                if (tl == 0) {
                    if (row < TP) {
#pragma unroll
                        for (int e = 0; e < 8; ++e) { p2a[e] = p2b[e] = p1a[e] = p1b[e] = 0.f; }
                    } else { const float* sp = P.in[I_SCV] + ((size_t)layer * 128 + ((row - TP) >> 2)) * 2 * FF2;
#pragma unroll
                        for (int e = 0; e < 8; ++e) { p2a[e] = sp[c0 + e]; p2b[e] = sp[FF + c0 + e]; p1a[e] = sp[FF2 + c0 + e]; p1b[e] = sp[FF2 + FF + c0 + e]; } }
                }
                float ca[8], cbv[8], o[8]; unpack8(ra[i], ca); unpack8(rbv[i], cbv);
#pragma unroll
                for (int e = 0; e < 8; ++e) { const float xa = ba[e] + wa[0][e] * p2a[e] + wa[1][e] * p1a[e] + wa[2][e] * ca[e]; const float xb = bb[e] + wb[0][e] * p2b[e] + wb[1][e] * p1b[e] + wb[2][e] * cbv[e];
                    o[e] = gelu_tanh(xa) * xb; p2a[e] = p1a[e]; p2b[e] = p1b[e]; p1a[e] = ca[e]; p1b[e] = cbv[e]; }
                u32x4 w; w.x = cvt_pk_bf16(o[0], o[1]); w.y = cvt_pk_bf16(o[2], o[3]); w.z = cvt_pk_bf16(o[4], o[5]); w.w = cvt_pk_bf16(o[6], o[7]);
                *(u32x4*)(up + (size_t)row * FF2 + c0) = w; }
        }
        __syncthreads();
    }
}

#define XB_TMO      128
#define XB_XCNT(j)  (256  + 64 * (j))
#define XB_XSUB(j)  (1280 + 64 * (j))
#define XB_XGEN(j)  (2304 + 64 * (j))
#define XB_TOP      3328
#define XB_TOPGEN   3392
#define XCD_BAR_WORDS 3456
#define XB_SPIN_CAP (1u << 18)

__device__ __forceinline__ unsigned xb_ld(unsigned* p)              { return __hip_atomic_load(p, __ATOMIC_RELAXED, __HIP_MEMORY_SCOPE_AGENT); }
__device__ __forceinline__ unsigned xb_add(unsigned* p, unsigned v) { return __hip_atomic_fetch_add(p, v, __ATOMIC_RELAXED, __HIP_MEMORY_SCOPE_AGENT); }
__device__ __forceinline__ unsigned xb_xcc_id() { return (unsigned)__builtin_amdgcn_s_getreg((3 << 11) | 20) & 0xFu; }
#define XB_SPIN(cond, bar) do { unsigned _sp = 0; while (cond) { __builtin_amdgcn_s_sleep(1); \
    if ((++_sp & 255u) == 0u) { if (xb_ld(&(bar)[XB_TMO])) break; if (_sp > XB_SPIN_CAP) { atomicAdd(&(bar)[XB_TMO], 1u); break; } } } } while (0)

struct XcdBarrier {
    unsigned* bar; unsigned x;
    volatile LAS unsigned* st;
};

__device__ __forceinline__ XcdBarrier xcd_barrier_post(unsigned* bar, volatile LAS unsigned* st) {
    XcdBarrier b; b.bar = bar; b.x = xb_xcc_id(); b.st = st;
    if (threadIdx.x == 0) (void)xb_add(&bar[XB_XCNT(b.x)], 1u);
    return b;
}
__device__ __forceinline__ void xcd_barrier_complete(unsigned* bar, unsigned x, unsigned& nloc, unsigned& nx) {
    const unsigned G = gridDim.x * gridDim.y * gridDim.z;
    unsigned sum, cnt, mine, sp = 0u;
    for (;;) {
        sum = 0u; cnt = 0u; mine = 0u;
#pragma unroll
        for (unsigned j = 0; j < 16; ++j) { const unsigned c = xb_ld(&bar[XB_XCNT(j)]); sum += c; cnt += (c > 0u) ? 1u : 0u; mine = (j == x) ? c : mine; }
        if (sum == G) break;
        __builtin_amdgcn_s_sleep(1);
        if ((++sp & 255u) == 0u) { if (xb_ld(&bar[XB_TMO])) break; if (sp > XB_SPIN_CAP) { atomicAdd(&bar[XB_TMO], 1u); break; } }
    }
    nloc = mine > 0u ? mine : 1u; nx = cnt > 0u ? cnt : 1u;
}

__device__ __forceinline__ void xcd_barrier(const XcdBarrier& b) {
    asm volatile("s_waitcnt vmcnt(0)" ::: "memory");
    __syncthreads();
    if (threadIdx.x == 0) {
        unsigned* bar = b.bar;
        __builtin_amdgcn_s_waitcnt(0);
        unsigned nloc = b.st[0], nx = b.st[1];
        if (nloc == 0u) { xcd_barrier_complete(bar, b.x, nloc, nx); b.st[0] = nloc; b.st[1] = nx; }
        const unsigned old = xb_add(&bar[XB_XSUB(b.x)], 1u);
        const unsigned gen = old / nloc;
        if (old + 1u == (gen + 1u) * nloc) {
            __builtin_amdgcn_fence(__ATOMIC_RELEASE, "agent");
            asm volatile("s_waitcnt vmcnt(0)" ::: "memory");
            const unsigned og = xb_add(&bar[XB_TOP], 1u);
            const unsigned tg = og / nx;
            if (og + 1u == (tg + 1u) * nx) xb_add(&bar[XB_TOPGEN], 1u);
            else XB_SPIN(xb_ld(&bar[XB_TOPGEN]) == tg, bar);
            __builtin_amdgcn_fence(__ATOMIC_ACQUIRE, "agent");
            xb_add(&bar[XB_XGEN(b.x)], 1u);
            asm volatile("s_waitcnt vmcnt(0)" ::: "memory");
        } else {
            XB_SPIN(xb_ld(&bar[XB_XGEN(b.x)]) == gen, bar);
            __builtin_amdgcn_fence(__ATOMIC_ACQUIRE, "agent");
            asm volatile("s_waitcnt vmcnt(0)" ::: "memory");
        }
    }
    __syncthreads();
}
constexpr int N_PHASES = 2 + 10 * 2 + 1;
__device__ __forceinline__ void run_phase(PRef P, const Ctx& c, int ph) {
    unsigned char* ws = P.ws;
    float* mod = (float*)(ws + WS_MOD);
    bf16_t* H = (bf16_t*)(ws + WS_H);
    bf16_t* zb = (bf16_t*)(ws + WS_Z); bf16_t* gb = (bf16_t*)(ws + WS_G); bf16_t* up = (bf16_t*)(ws + WS_UP);
    if (ph == 0) { phase_start(P, c); return; }
    if (ph == 1) { EpiAda E{mod, P.in[I_BADA]}; run_gemm(c, (const bf16_t*)(ws + WS_AADA), 1024, (const bf16_t*)(ws + WS_WADA), 256, 12288, 1024, E); return; }
    if (ph == N_PHASES - 1) { phase_final_norm(P, c); return; }
    const int layer = (ph - 2) / 10, sp = (ph - 2) % 10;
    switch (sp) {
    case 0: phase_norm(P, c, layer, 0, layer == 0); if (layer > 0) convert_layer_weights(P, c, layer, c.G == 256 ? 1 : 0); break;
    case 1: { EpiZ E{zb, gb, P.out, layer}; run_gemm(c, H, 1024, (const bf16_t*)(ws + WS_WIN), T, INP, 1024, E); } break;
    case 2: phase_scan(P, c, layer); break;
    case 3: { EpiGlu E{(const bf16_t*)(ws + WS_YPRE), H, P.in[I_BGLU] + layer * 256}; run_gemm(c, (const bf16_t*)(ws + WS_YPRE), 256, (const bf16_t*)(ws + WS_WGLU), T, 256, 256, E); } break;
    case 4: { EpiLift E0{gb, 0}; run_gemm(c, H, 1024, (const bf16_t*)(ws + WS_LA), T, 1024, 256, E0);
              EpiLift E1{gb, 1}; run_gemm(c, H + 256, 1024, (const bf16_t*)(ws + WS_LB), T, 1024, 512, E1);
              EpiLift E2{gb, 2}; run_gemm(c, H + 768, 1024, (const bf16_t*)(ws + WS_LC), T, 1024, 256, E2); } break;
    case 5: { EpiRes E{P.out, mod + (size_t)layer * NSEQ * 6144 + 2 * 1024}; run_gemm(c, gb, GC, (const bf16_t*)(ws + WS_WOUT3), T, 1024, 1024, E); } break;
    case 6: phase_norm(P, c, layer, 1, false); break;
    case 7: { EpiUp E{up, (bf16_t*)(ws + WS_HALO), P.out, layer}; run_gemm(c, H, 1024, (const bf16_t*)(ws + WS_WUP), T, FF2, 1024, E); } break;
    case 8: phase_conv(P, c, layer); break;
    case 9: { EpiRes E{P.out, mod + (size_t)layer * NSEQ * 6144 + 5 * 1024}; run_gemm(c, up, FF2, (const bf16_t*)(ws + WS_WDN), T, 1024, FF, E); } break;
    }
}

__global__ void __launch_bounds__(NTHREADS, 2) fwd_kernel(Params P, int ph_lo, int ph_hi) {
    extern __shared__ __attribute__((aligned(16))) unsigned char shm[];
    volatile LAS unsigned* bst = (volatile LAS unsigned*)((LAS unsigned char*)shm + (LDS_BYTES - 8));
    if (threadIdx.x == 0) { bst[0] = 0u; bst[1] = 0u; }
    __syncthreads();
    const XcdBarrier gbar = xcd_barrier_post((unsigned*)(P.ws + WS_BAR), bst);
    const int wave_s = __builtin_amdgcn_readfirstlane(threadIdx.x >> 6);
    for (int ph = ph_lo; ph < ph_hi; ++ph) {
        int lane_; asm volatile("v_mbcnt_lo_u32_b32 %0, -1, 0\n\tv_mbcnt_hi_u32_b32 %0, -1, %0" : "=v"(lane_));
        int tid_ = wave_s * 64 + lane_; asm volatile("" : "+v"(tid_));
        int bid_ = blockIdx.x; asm volatile("" : "+s"(bid_));
        Ctx c; c.tid = tid_; c.lane = tid_ & 63; c.wave = __builtin_amdgcn_readfirstlane(tid_ >> 6); c.b = bid_; c.G = gridDim.x; c.lds = shm;
        const __attribute__((address_space(4))) Params* kp = (const __attribute__((address_space(4))) Params*)__builtin_amdgcn_kernarg_segment_ptr();
        asm volatile("" : "+s"(kp));
        run_phase(*kp, c, ph);
        if (ph + 1 < ph_hi) xcd_barrier(gbar);
    }
}

extern "C" void kernel_launch(void* const* d_in, const int* in_sizes, int n_in, void* d_out, int out_size, void* d_ws, size_t ws_size, hipStream_t stream) {
    static int grid = 0;
    if (grid == 0) {
        int dev = 0, cus = 0, per_cu = 0;
        (void)hipGetDevice(&dev); (void)hipDeviceGetAttribute(&cus, hipDeviceAttributeMultiprocessorCount, dev);
        (void)hipFuncSetAttribute((const void*)fwd_kernel, hipFuncAttributeMaxDynamicSharedMemorySize, LDS_BYTES);
        (void)hipOccupancyMaxActiveBlocksPerMultiprocessor(&per_cu, (const void*)fwd_kernel, NTHREADS, LDS_BYTES);
        (void)hipGetLastError();
        if (per_cu < 1) per_cu = 1;
        grid = cus;
        if (ws_size < WS_END) fprintf(stderr, "kernel_launch: workspace too small: %zu < %zu\n", ws_size, (size_t)WS_END);
        if (n_in != 46) fprintf(stderr, "kernel_launch: expected 46 inputs, got %d\n", n_in);
    }
    if (ws_size < WS_END || n_in != 46) return;
    Params p{};
    for (int i = 0; i < 46; ++i) p.in[i] = (const float*)d_in[i];
    p.out = (float*)d_out; p.ws = (unsigned char*)d_ws;
#if N_LAUNCH_MODE == 1
    (void)hipMemsetAsync((unsigned char*)d_ws + WS_BAR, 0, XCD_BAR_WORDS * 4, stream);
    int lo = 0, hi = N_PHASES;
    void* args[] = {&p, &lo, &hi};
    hipError_t e = hipLaunchCooperativeKernel((const void*)fwd_kernel, dim3(grid), dim3(NTHREADS), args, LDS_BYTES, stream);
    if (e != hipSuccess) fprintf(stderr, "cooperative launch failed: %s (grid %d)\n", hipGetErrorString(e), grid);
#else
    for (int ph = 0; ph < N_PHASES; ++ph) hipLaunchKernelGGL(fwd_kernel, dim3(grid), dim3(NTHREADS), LDS_BYTES, stream, p, ph, ph + 1);
#endif
}
```

```cpp
#include <hip/hip_runtime.h>
#include <hip/hip_cooperative_groups.h>
#include <cstdio>
#include <cstdint>
namespace cg = cooperative_groups;

#ifndef N_LAUNCH_MODE
#define N_LAUNCH_MODE 1
#endif

#define LAS __attribute__((address_space(3)))
typedef unsigned short bf16_t;
typedef short bf16x8 __attribute__((ext_vector_type(8)));
typedef float f32x4 __attribute__((ext_vector_type(4)));
typedef unsigned u32x4 __attribute__((ext_vector_type(4)));
typedef unsigned u32x2 __attribute__((ext_vector_type(2)));
typedef float f32x2v __attribute__((ext_vector_type(2)));

constexpr int D = 1024, TP = 16384, TS = 512, T = TP + TS, NSEQ = 136;
constexpr int ZC = 2944, GC = 3072, INC = 6016, INP = 6144, FF = 2816, FF2 = 5632, RWC = 1664;
constexpr int NTHREADS = 512, NWAVES = 8;
constexpr int LDS_BYTES = 147456;

constexpr size_t O_YP = 0, O_YS = 16777216, O_S5P = 17301504, O_SHP = 17334272, O_RWP = 17360896, O_HGP = 17885184, O_CVP = 18147328,
                 O_S5S = 18327552, O_SHS = 18851840, O_RWS = 19277824, O_HGS = 27666432, O_CVS = 31860736;

constexpr size_t WS_MOD = 4096;
constexpr size_t WS_WIN = WS_MOD + (size_t)2 * NSEQ * 6144 * 4;
constexpr size_t WS_LA = WS_WIN + (size_t)INP * 1024 * 2;
constexpr size_t WS_LB = WS_LA + (size_t)1024 * 256 * 2;
constexpr size_t WS_LC = WS_LB + (size_t)1024 * 512 * 2;
constexpr size_t WS_WGLU = WS_LC + (size_t)1024 * 256 * 2;
constexpr size_t WS_WOUT3 = WS_WGLU + (size_t)256 * 256 * 2;
constexpr size_t WS_WUP = WS_WOUT3 + (size_t)1024 * 3072 * 2;
constexpr size_t WS_WDN = WS_WUP + (size_t)FF2 * 1024 * 2;
constexpr size_t WS_H = WS_WDN + (size_t)1024 * FF * 2;
constexpr size_t WS_YPRE = WS_H + (size_t)T * 1024 * 2;
constexpr size_t WS_HALO = WS_YPRE + (size_t)T * 256 * 2;
constexpr size_t WS_BIG = WS_HALO + (size_t)66 * 2 * FF2 * 2;
constexpr size_t WS_Z = WS_BIG, WS_G = WS_Z + (size_t)T * ZC * 2, WS_UP = WS_BIG;
constexpr size_t WS_WADA = WS_BIG, WS_AADA = WS_WADA + (size_t)12288 * 1024 * 2;
constexpr size_t WS_BAR = WS_G + (size_t)T * GC * 2;
constexpr size_t WS_END = WS_BAR + 16384;

struct Params { const float* in[46]; float* out; unsigned char* ws; };
typedef const __attribute__((address_space(4))) Params& PRef;

enum { I_XP = 0, I_XS, I_CP, I_CS, I_SS5, I_SSH, I_SRW, I_SHG, I_SCV, I_WADA, I_BADA, I_GMIX, I_GFFN, I_WIN, I_LRE, I_LIM, I_LDT, I_BRE, I_BIM, I_CRE, I_CIM, I_S5D, I_WGLU, I_BGLU,
       I_MU, I_W0, I_W2, I_A0, I_A2, I_G2, I_KK, I_KA, I_RK, I_LNW, I_LNB, I_HLB, I_HNORM, I_LFA, I_LFB, I_LFC, I_WOUT, I_WUP, I_CW, I_CB, I_WDN, I_FG };

__device__ __forceinline__ unsigned short f2bf(float f) { unsigned u = __float_as_uint(f); u += 0x7FFFu + ((u >> 16) & 1u); return (unsigned short)(u >> 16); }
__device__ __forceinline__ float bf2f(unsigned short b) { return __uint_as_float(((unsigned)b) << 16); }
__device__ __forceinline__ float bflo(unsigned w) { return __uint_as_float(w << 16); }
__device__ __forceinline__ float bfhi(unsigned w) { return __uint_as_float(w & 0xFFFF0000u); }
typedef __bf16 bf16x2_t __attribute__((ext_vector_type(2)));
__device__ __forceinline__ unsigned cvt_pk_bf16(float lo, float hi) {
    bf16x2_t v; v.x = (__bf16)lo; v.y = (__bf16)hi; return __builtin_bit_cast(unsigned, v); }
__device__ __forceinline__ float fsigmoid(float x) { return __builtin_amdgcn_rcpf(1.0f + __expf(-x)); }
__device__ __forceinline__ float gelu_tanh(float x) { return x * fsigmoid(1.5957691216f * (x + 0.044715f * x * x * x)); }
#define DPP_ADD(v, CTRL) ((v) + __int_as_float(__builtin_amdgcn_update_dpp(0, __float_as_int(v), (CTRL), 0xF, 0xF, true)))
__device__ __forceinline__ float wave_sum(float v) {
    v = DPP_ADD(v, 0xB1); v = DPP_ADD(v, 0x4E); v = DPP_ADD(v, 0x141); v = DPP_ADD(v, 0x140);
    const float r0 = __int_as_float(__builtin_amdgcn_readlane(__float_as_int(v), 0)), r1 = __int_as_float(__builtin_amdgcn_readlane(__float_as_int(v), 16));
    const float r2 = __int_as_float(__builtin_amdgcn_readlane(__float_as_int(v), 32)), r3 = __int_as_float(__builtin_amdgcn_readlane(__float_as_int(v), 48));
    return (r0 + r1) + (r2 + r3);
}
__device__ __forceinline__ float red8(float v) { v = DPP_ADD(v, 0xB1); v = DPP_ADD(v, 0x4E); v = DPP_ADD(v, 0x141); return v; }
__device__ __forceinline__ int row2seq(int row) { return row < TP ? (row >> 11) : 8 + ((row - TP) >> 2); }
#define LDS_FENCE() asm volatile("s_waitcnt lgkmcnt(0)" ::: "memory")

namespace pg8 {
constexpr int BM = 256, BK = 64, HALF = 128, HTB = HALF * BK * 2, STAGE_BYTES = 8 * HTB, NXCD = 8, WGM = 4;
__host__ __device__ __forceinline__ int lds_byte(int r, int c) { const int st = (r >> 4) * 2 + (c >> 5), rr = r & 15, cc = c & 31, ob = rr * 64 + cc * 2; return st * 1024 + (ob ^ (((ob >> 9) & 1) << 5)); }
__host__ __device__ __forceinline__ void stage_rc(int b, int& R, int& C) { const int st = b / 1024, sb = b % 1024, swz = sb ^ (((sb >> 9) & 1) << 5); R = (st >> 1) * 16 + swz / 64; C = (st & 1) * 32 + (swz % 64) / 2; }
__host__ __device__ __forceinline__ int perm32(int rho) { const int n = rho >> 4, i = rho & 15; return 8 * (i >> 2) + 4 * n + (i & 3); }
struct Unit { int pm, pn; };
struct Gemm { const bf16_t* A; const bf16_t* Bt; int M, N, K, lda; };
struct StaticOrder {
    int nM, nN, nwg, G, c;
    __device__ void init(int M, int N, int G_, int c_) { nM = M / BM; nN = N / BM; nwg = nM * nN; G = G_; c = c_; }
    __device__ bool next(int i, Unit& u) const {
        const long L = (long)i * G + c; if (L >= nwg) return false;
        int wgid = (int)L; { const int q = nwg / NXCD, r = nwg % NXCD, xcd = wgid % NXCD, off = wgid / NXCD; wgid = (xcd < r ? xcd * (q + 1) : r * (q + 1) + (xcd - r) * q) + off; }
        const int nig = WGM * nN, gid = wgid / nig, fm = gid * WGM, gsz = (nM - fm) < WGM ? (nM - fm) : WGM;
        u.pm = fm + ((wgid % nig) % gsz); u.pn = (wgid % nig) / gsz; return true;
    }
};

template <class Epi>
__device__ __forceinline__ void gemm_phase(LAS unsigned char* lds, const Gemm g, const StaticOrder& S, const Epi& E, const int tid) {
    const int wid = __builtin_amdgcn_readfirstlane(tid >> 6), lane = tid & 63, wr = wid >> 2, wc = wid & 3, fr = lane & 15, fq = lane >> 4;
    const int K = g.K, nt = K / BK, lda = g.lda;
    unsigned voffA[2], voffB[2];
#pragma unroll
    for (int i = 0; i < 2; ++i) { int R, C; stage_rc(tid * 16 + i * 8192, R, C); const int Rb = Epi::PERM ? ((R & ~31) + perm32(R & 31)) : R;
        voffA[i] = (unsigned)(R * lda + C) * 2u; voffB[i] = (unsigned)(Rb * K + C) * 2u; }
    const size_t kstep = (size_t)(BK * 2);
    const size_t hstepA = (size_t)HALF * lda * 2, hstepB = (size_t)HALF * K * 2;
    const size_t tstepA = 2 * hstepA, tstepB = 2 * hstepB;
    const unsigned ldsw = (unsigned)wid * 1024u;
    const int aoff = lds_byte(wr * 64 + fr, fq * 8), boff = lds_byte(wc * 32 + fr, fq * 8);
#define PG8_SA(b, h) (((b) * 2 + (h)) * HTB)
#define PG8_SB(b, h) ((4 + (b) * 2 + (h)) * HTB)
#define PG8_STAGE(bufoff, gbase, voff) do { _Pragma("unroll") for (int _i = 0; _i < 2; ++_i) \
        __builtin_amdgcn_global_load_lds((const unsigned*)((const char*)(gbase) + (voff)[_i]), (LAS unsigned*)(lds + (bufoff) + ldsw + _i * 8192), 16, 0, 0); } while (0)
#define PG8_LDA(dst, b, h) do { _Pragma("unroll") for (int m = 0; m < 4; ++m) _Pragma("unroll") for (int k = 0; k < 2; ++k) dst[m][k] = *(const LAS bf16x8*)(lds + PG8_SA(b, h) + aoff + m * 2048 + k * 1024); } while (0)
#define PG8_LDB(dst, b, h) do { _Pragma("unroll") for (int n = 0; n < 2; ++n) _Pragma("unroll") for (int k = 0; k < 2; ++k) dst[n][k] = *(const LAS bf16x8*)(lds + PG8_SB(b, h) + boff + n * 2048 + k * 1024); } while (0)
#define PG8_MMA(ai, bj, At, Bt) do { __builtin_amdgcn_s_setprio(1); _Pragma("unroll") for (int m = 0; m < 4; ++m) _Pragma("unroll") for (int n = 0; n < 2; ++n) _Pragma("unroll") for (int k = 0; k < 2; ++k) \
        acc[ai][bj][m][n] = __builtin_amdgcn_mfma_f32_16x16x32_bf16(Bt[n][k], At[m][k], acc[ai][bj][m][n], 0, 0, 0); __builtin_amdgcn_s_setprio(0); } while (0)
#define PG8_WAIT_V(n) asm volatile("s_waitcnt vmcnt(" #n ")" ::: "memory")
#define PG8_WAIT_L(n) asm volatile("s_waitcnt lgkmcnt(" #n ")" ::: "memory")
#define PG8_BAR __builtin_amdgcn_s_barrier()
#define PG8_SCHED __builtin_amdgcn_sched_barrier(0)
    Unit cur, nxt; int ui = 0;
    if (!S.next(0, cur)) return;
    f32x4 acc[2][2][4][2];
#pragma unroll
    for (int a = 0; a < 2; ++a)
#pragma unroll
        for (int b = 0; b < 2; ++b)
#pragma unroll
            for (int m = 0; m < 4; ++m)
#pragma unroll
                for (int n = 0; n < 2; ++n) acc[a][b][m][n] = (f32x4){0.f, 0.f, 0.f, 0.f};
    bf16x8 At[4][2], B0[2][2], B1[2][2];
    const char* cA = (const char*)g.A + (size_t)cur.pm * tstepA; const char* cB = (const char*)g.Bt + (size_t)cur.pn * tstepB;
    PG8_STAGE(PG8_SB(0, 0), cB, voffB); PG8_STAGE(PG8_SA(0, 0), cA, voffA); PG8_STAGE(PG8_SB(0, 1), cB + hstepB, voffB); PG8_STAGE(PG8_SA(0, 1), cA + hstepA, voffA);
    if (wr == 1) PG8_BAR;
    PG8_WAIT_V(4); PG8_BAR;
    PG8_STAGE(PG8_SB(1, 0), cB + kstep, voffB); PG8_STAGE(PG8_SA(1, 0), cA + kstep, voffA); PG8_STAGE(PG8_SB(1, 1), cB + hstepB + kstep, voffB);
    PG8_WAIT_V(6); PG8_BAR;
    for (;;) {
        const bool has_next = S.next(ui + 1, nxt);
        const char* nA = has_next ? (const char*)g.A + (size_t)nxt.pm * tstepA : cA; const char* nB = has_next ? (const char*)g.Bt + (size_t)nxt.pn * tstepB : cB;
        for (int t = 0; t < nt; t += 2) {
            const bool last = (t == nt - 2);
            const char* a1 = cA + (size_t)(t + 1) * kstep;
            const char* a2 = last ? nA : cA + (size_t)(t + 2) * kstep; const char* b2 = last ? nB : cB + (size_t)(t + 2) * kstep;
            const char* a3 = a2 + kstep; const char* b3 = b2 + kstep;
            PG8_LDB(B0, 0, 0); PG8_SCHED; PG8_LDA(At, 0, 0); PG8_STAGE(PG8_SA(1, 1), a1 + hstepA, voffA);
            PG8_WAIT_L(8); PG8_BAR; PG8_WAIT_L(0); PG8_MMA(0, 0, At, B0); PG8_BAR; PG8_SCHED;
            PG8_LDB(B1, 0, 1); PG8_STAGE(PG8_SB(0, 0), b2, voffB);
            PG8_BAR; PG8_WAIT_L(0); PG8_MMA(0, 1, At, B1); PG8_BAR;
            PG8_LDA(At, 0, 1); PG8_STAGE(PG8_SA(0, 0), a2, voffA);
            PG8_BAR; PG8_WAIT_L(0); PG8_MMA(1, 0, At, B0); PG8_BAR; PG8_SCHED;
            PG8_STAGE(PG8_SB(0, 1), b2 + hstepB, voffB);
            PG8_WAIT_V(6); PG8_BAR; PG8_MMA(1, 1, At, B1); PG8_BAR;
            PG8_LDB(B0, 1, 0); PG8_SCHED; PG8_LDA(At, 1, 0); PG8_STAGE(PG8_SA(0, 1), a2 + hstepA, voffA);
            PG8_WAIT_L(8); PG8_BAR; PG8_WAIT_L(0); PG8_MMA(0, 0, At, B0); PG8_BAR; PG8_SCHED;
            PG8_LDB(B1, 1, 1); PG8_STAGE(PG8_SB(1, 0), b3, voffB);
            PG8_BAR; PG8_WAIT_L(0); PG8_MMA(0, 1, At, B1); PG8_BAR;
            PG8_LDA(At, 1, 1); PG8_STAGE(PG8_SA(1, 0), a3, voffA);
            PG8_BAR; PG8_WAIT_L(0); PG8_MMA(1, 0, At, B0); PG8_BAR; PG8_SCHED;
            PG8_STAGE(PG8_SB(1, 1), b3 + hstepB, voffB);
            PG8_WAIT_V(6); PG8_BAR; PG8_MMA(1, 1, At, B1); PG8_BAR;
        }
        { int fr_ = fr, fq_ = fq; asm volatile("" : "+v"(fr_), "+v"(fq_));
          E(acc, cur, wr, wc, fr_, fq_); }
        if (!has_next) break;
#pragma unroll
        for (int a = 0; a < 2; ++a)
#pragma unroll
            for (int b = 0; b < 2; ++b)
#pragma unroll
                for (int m = 0; m < 4; ++m)
#pragma unroll
                    for (int n = 0; n < 2; ++n) acc[a][b][m][n] = (f32x4){0.f, 0.f, 0.f, 0.f};
        cur = nxt; cA = nA; cB = nB; ++ui;
    }
    PG8_WAIT_V(0);
    if (wr == 0) PG8_BAR;
    PG8_BAR;
#undef PG8_SA
#undef PG8_SB
#undef PG8_STAGE
#undef PG8_LDA
#undef PG8_LDB
#undef PG8_MMA
#undef PG8_WAIT_V
#undef PG8_WAIT_L
#undef PG8_BAR
#undef PG8_SCHED
}
}
using pg8::Unit;
typedef f32x4 AccT[2][2][4][2];

#define EPI_LOOP_PERM(...) \
    _Pragma("unroll") for (int ai = 0; ai < 2; ++ai) _Pragma("unroll") for (int m = 0; m < 4; ++m) { const int row = u.pm * 256 + ai * 128 + wr * 64 + m * 16 + fr; \
        _Pragma("unroll") for (int bj = 0; bj < 2; ++bj) { const int col0 = u.pn * 256 + bj * 128 + wc * 32 + 8 * fq; const f32x4 v0 = acc[ai][bj][m][0], v1 = acc[ai][bj][m][1]; __VA_ARGS__ } }
#define EPI_LOOP_NOPERM(...) \
    _Pragma("unroll") for (int ai = 0; ai < 2; ++ai) _Pragma("unroll") for (int m = 0; m < 4; ++m) { const int row = u.pm * 256 + ai * 128 + wr * 64 + m * 16 + fr; \
        _Pragma("unroll") for (int bj = 0; bj < 2; ++bj) _Pragma("unroll") for (int n = 0; n < 2; ++n) { const int col0 = u.pn * 256 + bj * 128 + wc * 32 + 16 * n + 4 * fq; const f32x4 v = acc[ai][bj][m][n]; __VA_ARGS__ } }

__device__ __forceinline__ u32x4 pack8(f32x4 a, f32x4 b) { u32x4 w; w.x = cvt_pk_bf16(a[0], a[1]); w.y = cvt_pk_bf16(a[2], a[3]); w.z = cvt_pk_bf16(b[0], b[1]); w.w = cvt_pk_bf16(b[2], b[3]); return w; }

struct EpiAda {
    static constexpr bool PERM = false;
    float* mod; const float* bada;
    __device__ __forceinline__ void operator()(const AccT& acc, const Unit& u, int wr, int wc, int fr, int fq) const {
        EPI_LOOP_NOPERM( if (row < NSEQ) { const int layer = col0 / 6144, c = col0 - layer * 6144; const f32x4 b = *(const f32x4*)(bada + (size_t)layer * 6144 + c);
            *(f32x4*)(mod + ((size_t)layer * NSEQ + row) * 6144 + c) = v + b; } )
    }
};
struct EpiZ {
    static constexpr bool PERM = true;
    bf16_t* zb; bf16_t* gb; float* out; int layer;
    __device__ __forceinline__ void operator()(const AccT& acc, const Unit& u, int wr, int wc, int fr, int fq) const {
        EPI_LOOP_PERM(
            if (col0 < ZC) { *(u32x4*)(zb + (size_t)row * ZC + col0) = pack8(v0, v1);
                if (col0 >= 256 && col0 < 1920) { const bool last = row < TP ? ((row & 2047) == 2047) : ((row & 3) == 3);
                    if (last) { float* o = row < TP ? out + O_SHP + (size_t)(layer * 8 + (row >> 11)) * RWC : out + O_SHS + (size_t)(layer * 128 + ((row - TP) >> 2)) * RWC;
                        *(f32x4*)(o + col0 - 256) = v0; *(f32x4*)(o + col0 - 252) = v1; } } }
            else if (col0 < INC) { f32x4 s0, s1;
                _Pragma("unroll") for (int j = 0; j < 4; ++j) { s0[j] = fsigmoid(v0[j]); s1[j] = fsigmoid(v1[j]); }
                *(u32x4*)(gb + (size_t)row * GC + (col0 - ZC)) = pack8(s0, s1); } )
    }
};
struct EpiGlu {
    static constexpr bool PERM = true;
    const bf16_t* ypre; bf16_t* yabc; const float* bglu;
    __device__ __forceinline__ void operator()(const AccT& acc, const Unit& u, int wr, int wc, int fr, int fq) const {
#pragma unroll
        for (int bj = 0; bj < 2; ++bj) { const int col0 = u.pn * 256 + bj * 128 + wc * 32 + 8 * fq;
            const f32x4 b0 = *(const f32x4*)(bglu + col0), b1 = *(const f32x4*)(bglu + col0 + 4);
#pragma unroll
            for (int ai = 0; ai < 2; ++ai)
#pragma unroll
                for (int m = 0; m < 4; ++m) { const int row = u.pm * 256 + ai * 128 + wr * 64 + m * 16 + fr;
                    const f32x4 v0 = acc[ai][bj][m][0] + b0, v1 = acc[ai][bj][m][1] + b1;
                    const u32x4 y = *(const u32x4*)(ypre + (size_t)row * 256 + col0);
                    f32x4 o0, o1;
                    o0[0] = bflo(y.x) * fsigmoid(v0[0]); o0[1] = bfhi(y.x) * fsigmoid(v0[1]); o0[2] = bflo(y.y) * fsigmoid(v0[2]); o0[3] = bfhi(y.y) * fsigmoid(v0[3]);
                    o1[0] = bflo(y.z) * fsigmoid(v1[0]); o1[1] = bfhi(y.z) * fsigmoid(v1[1]); o1[2] = bflo(y.w) * fsigmoid(v1[2]); o1[3] = bfhi(y.w) * fsigmoid(v1[3]);
                    *(u32x4*)(yabc + (size_t)row * 1024 + col0) = pack8(o0, o1);
                    asm volatile("" ::: "memory"); } }
    }
};
struct EpiLift {
    static constexpr bool PERM = true;
    bf16_t* gb; int j;
    __device__ __forceinline__ void operator()(const AccT& acc, const Unit& u, int wr, int wc, int fr, int fq) const {
        EPI_LOOP_PERM( bf16_t* pg = gb + (size_t)row * GC + j * 1024 + col0; bf16_t* pd = gb + (size_t)row * GC + col0; const u32x4 g = *(const u32x4*)pg; f32x4 o0, o1;
            o0[0] = bflo(g.x) * v0[0]; o0[1] = bfhi(g.x) * v0[1]; o0[2] = bflo(g.y) * v0[2]; o0[3] = bfhi(g.y) * v0[3];
            o1[0] = bflo(g.z) * v1[0]; o1[1] = bfhi(g.z) * v1[1]; o1[2] = bflo(g.w) * v1[2]; o1[3] = bfhi(g.w) * v1[3];
            if (j > 0) { const u32x4 d = *(const u32x4*)pd;
                o0[0] += bflo(d.x); o0[1] += bfhi(d.x); o0[2] += bflo(d.y); o0[3] += bfhi(d.y); o1[0] += bflo(d.z); o1[1] += bfhi(d.z); o1[2] += bflo(d.w); o1[3] += bfhi(d.w); }
            *(u32x4*)pd = pack8(o0, o1); )
    }
};
struct EpiRes {
    static constexpr bool PERM = false;
    float* hres; const float* gate;
    __device__ __forceinline__ void operator()(const AccT& acc, const Unit& u, int wr, int wc, int fr, int fq) const {
        EPI_LOOP_NOPERM( const f32x4 g = *(const f32x4*)(gate + (size_t)row2seq(row) * 6144 + col0); float* p = hres + (size_t)row * 1024 + col0; *(f32x4*)p = *(const f32x4*)p + g * v; )
    }
};
struct EpiUp {
    static constexpr bool PERM = true;
    bf16_t* up; bf16_t* halo; float* out; int layer;
    __device__ __forceinline__ void operator()(const AccT& acc, const Unit& u, int wr, int wc, int fr, int fq) const {
        EPI_LOOP_PERM( const u32x4 w = pack8(v0, v1); *(u32x4*)(up + (size_t)row * FF2 + col0) = w;
            const int r = row & 255; if (r >= 254) *(u32x4*)(halo + ((size_t)(row >> 8) * 2 + (r - 254)) * FF2 + col0) = w;
            const int tl = row < TP ? (row & 2047) - 2046 : (row & 3) - 2;
            if (tl >= 0) { float* o = row < TP ? out + O_CVP + ((size_t)(layer * 8 + (row >> 11)) * 2 + tl) * FF2 : out + O_CVS + ((size_t)(layer * 128 + ((row - TP) >> 2)) * 2 + tl) * FF2;
                *(f32x4*)(o + col0) = v0; *(f32x4*)(o + col0 + 4) = v1; } )
    }
};

struct Ctx { int tid, lane, wave, b, G; unsigned char* lds; };

template <class Epi>
__device__ __forceinline__ void run_gemm(const Ctx& c, const bf16_t* A, int lda, const bf16_t* Bt, int M, int N, int K, const Epi& E) {
    pg8::Gemm g; g.A = A; g.Bt = Bt; g.M = M; g.N = N; g.K = K; g.lda = lda;
    pg8::StaticOrder S; S.init(M, N, c.G, c.b);
    pg8::gemm_phase<Epi>((LAS unsigned char*)c.lds, g, S, E, c.tid);
}

__device__ __forceinline__ void transpose_item(const float* W, int N, bf16_t* WT, int ldk, int koff, int nrep, float* scr, int item, int lane) {
    const int nblk = N / 32, kb = item / nblk, nb = item % nblk, k0 = 64 * kb, n0 = 32 * nb;
#pragma unroll
    for (int i = 0; i < 8; ++i) { const int kk = 8 * i + (lane >> 3), cq = 4 * (lane & 7);
        const f32x4 w = *(const f32x4*)(W + (size_t)(k0 + kk) * N + n0 + cq);
        scr[kk * 33 + cq] = w[0]; scr[kk * 33 + cq + 1] = w[1]; scr[kk * 33 + cq + 2] = w[2]; scr[kk * 33 + cq + 3] = w[3]; }
    LDS_FENCE();
    const int cc = lane & 7;
#pragma unroll
    for (int j = 0; j < 4; ++j) { const int n = (lane >> 3) + 8 * j; const float* s = scr + (8 * cc) * 33 + n;
        u32x4 o; o.x = cvt_pk_bf16(s[0 * 33], s[1 * 33]); o.y = cvt_pk_bf16(s[2 * 33], s[3 * 33]); o.z = cvt_pk_bf16(s[4 * 33], s[5 * 33]); o.w = cvt_pk_bf16(s[6 * 33], s[7 * 33]);
        for (int r = 0; r < nrep; ++r) *(u32x4*)(WT + (size_t)(n0 + n) * ldk + koff + r * 1024 + k0 + 8 * cc) = o; }
    LDS_FENCE();
}
struct TJob { const float* W; int K, N; bf16_t* WT; int ldk, nrep; };
__device__ __forceinline__ void convert_jobs(const Ctx& c, const TJob* jobs, int njobs) {
    float* scr = (float*)(c.lds) + c.wave * (64 * 33);
    const int gw = c.b * NWAVES + c.wave, NGW = c.G * NWAVES;
    int base = 0;
    for (int j = 0; j < njobs; ++j) {
        const int items = (jobs[j].K / 64) * (jobs[j].N / 32);
        int first = (gw - (base % NGW) + NGW) % NGW;
        for (int it = first; it < items; it += NGW) transpose_item(jobs[j].W, jobs[j].N, jobs[j].WT, jobs[j].ldk, 0, jobs[j].nrep, scr, it, c.lane);
        base += items;
    }
}
__device__ __forceinline__ void convert_layer_weights(PRef P, const Ctx& c, int layer, int which = 0) {
    unsigned char* ws = P.ws;
    TJob jobs[8];
    jobs[0] = TJob{P.in[I_WIN] + (size_t)layer * 1024 * INC, 1024, INC, (bf16_t*)(ws + WS_WIN), 1024, 1};
    jobs[1] = TJob{P.in[I_WUP] + (size_t)layer * 1024 * FF2, 1024, FF2, (bf16_t*)(ws + WS_WUP), 1024, 1};
    jobs[2] = TJob{P.in[I_WDN] + (size_t)layer * FF * 1024, FF, 1024, (bf16_t*)(ws + WS_WDN), FF, 1};
    jobs[3] = TJob{P.in[I_WOUT] + (size_t)layer * 1024 * 1024, 1024, 1024, (bf16_t*)(ws + WS_WOUT3), 1024, 1};
    jobs[4] = TJob{P.in[I_LFB] + (size_t)layer * 512 * 1024, 512, 1024, (bf16_t*)(ws + WS_LB), 512, 1};
    jobs[5] = TJob{P.in[I_LFA] + (size_t)layer * 256 * 1024, 256, 1024, (bf16_t*)(ws + WS_LA), 256, 1};
    jobs[6] = TJob{P.in[I_LFC] + (size_t)layer * 256 * 1024, 256, 1024, (bf16_t*)(ws + WS_LC), 256, 1};
    jobs[7] = TJob{P.in[I_WGLU] + (size_t)layer * 256 * 256, 256, 256, (bf16_t*)(ws + WS_WGLU), 256, 1};
#pragma unroll
    for (int j = 0; j < 8; ++j) { if ((which == 1 && j != 0) || (which == 2 && j == 0)) continue; TJob one = jobs[j]; convert_jobs(c, &one, 1); }
}

__device__ __forceinline__ void phase_start(PRef P, const Ctx& c) {
    unsigned char* ws = P.ws;
    for (int l = 0; l < 2; ++l) { TJob one{P.in[I_WADA] + (size_t)l * 1024 * 6144, 1024, 6144, (bf16_t*)(ws + WS_WADA) + (size_t)l * 6144 * 1024, 1024, 1}; convert_jobs(c, &one, 1); }
    convert_layer_weights(P, c, 0, c.G == 256 ? 1 : 0);
    bf16_t* aada = (bf16_t*)(ws + WS_AADA);
    for (int i = c.b * NTHREADS + c.tid; i < 256 * 1024; i += c.G * NTHREADS) {
        const int r = i >> 10, k = i & 1023; float v = 0.f;
        if (r < NSEQ) { const float x = r < 8 ? P.in[I_CP][r * 1024 + k] : P.in[I_CS][(r - 8) * 1024 + k]; v = x * fsigmoid(x); }
        aada[i] = f2bf(v);
    }
}

__device__ __forceinline__ void phase_norm(PRef P, const Ctx& c, int layer, int which, bool first) {
    const float* mod = (const float*)(P.ws + WS_MOD) + (size_t)layer * NSEQ * 6144;
    const float* gw_ = P.in[which ? I_GFFN : I_GMIX] + layer * 1024;
    bf16_t* H = (bf16_t*)(P.ws + WS_H);
    const int gw = c.b * NWAVES + c.wave, NGW = c.G * NWAVES;
    for (int row = gw; row < T; row += NGW) {
        const float* src = first ? (row < TP ? P.in[I_XP] + (size_t)row * 1024 : P.in[I_XS] + (size_t)(row - TP) * 1024) : P.out + (size_t)row * 1024;
        const float* m = mod + (size_t)row2seq(row) * 6144 + (which ? 3 : 0) * 1024;
        f32x4 v[4]; float ss = 0.f;
#pragma unroll
        for (int j = 0; j < 4; ++j) { v[j] = *(const f32x4*)(src + 256 * j + 4 * c.lane); ss += (v[j][0] * v[j][0] + v[j][1] * v[j][1]) + (v[j][2] * v[j][2] + v[j][3] * v[j][3]); }
        const float rstd = rsqrtf(wave_sum(ss) * (1.f / 1024.f) + 1e-6f);
#pragma unroll
        for (int j = 0; j < 4; ++j) { const int col = 256 * j + 4 * c.lane;
            const f32x4 g = *(const f32x4*)(gw_ + col), sh = *(const f32x4*)(m + col), sc = *(const f32x4*)(m + 1024 + col);
            if (first) *(f32x4*)(P.out + (size_t)row * 1024 + col) = v[j];
            f32x4 h;
#pragma unroll
            for (int e = 0; e < 4; ++e) h[e] = v[j][e] * rstd * g[e] * (1.f + sc[e]) + sh[e];
            u32x2 w; w.x = cvt_pk_bf16(h[0], h[1]); w.y = cvt_pk_bf16(h[2], h[3]);
            *(u32x2*)(H + (size_t)row * 1024 + col) = w; }
    }
}
__device__ __forceinline__ void phase_final_norm(PRef P, const Ctx& c) {
    const float* fg = P.in[I_FG];
    const int gw = c.b * NWAVES + c.wave, NGW = c.G * NWAVES;
    for (int row = gw; row < T; row += NGW) {
        float* src = P.out + (size_t)row * 1024;
        f32x4 v[4]; float ss = 0.f;
#pragma unroll
        for (int j = 0; j < 4; ++j) { v[j] = *(const f32x4*)(src + 256 * j + 4 * c.lane); ss += (v[j][0] * v[j][0] + v[j][1] * v[j][1]) + (v[j][2] * v[j][2] + v[j][3] * v[j][3]); }
        const float rstd = rsqrtf(wave_sum(ss) * (1.f / 1024.f) + 1e-6f);
#pragma unroll
        for (int j = 0; j < 4; ++j) { const int col = 256 * j + 4 * c.lane; const f32x4 g = *(const f32x4*)(fg + col); *(f32x4*)(src + col) = v[j] * rstd * g; }
    }
}

struct SeqInfo { int n, L, row0; bool prompt; };
__device__ __forceinline__ SeqInfo seq_info(int s) { SeqInfo q; q.prompt = s < 8; q.n = q.prompt ? s : s - 8; q.L = q.prompt ? 2048 : 4; q.row0 = q.prompt ? s * 2048 : TP + (s - 8) * 4; return q; }

__device__ __forceinline__ void rwkv_prefetch(const bf16_t* zb, const SeqInfo& q, int h, int t0, int tid, u32x4 (&pre)[3]) {
    const int len = (q.L - t0) < 32 ? (q.L - t0) : 32;
#pragma unroll
    for (int it = 0; it < 3; ++it) { const int idx = tid + it * NTHREADS; pre[it] = (u32x4){0u, 0u, 0u, 0u};
        if (idx < 33 * 40 && t0 < q.L) { const int rr = idx / 40, vec = idx - rr * 40; const int pc = vec < 24 ? (vec >> 3) * 512 + h * 64 + (vec & 7) * 8 : 1536 + (vec - 24) * 8; const int tg = t0 - 1 + rr;
            if (tg >= 0 && rr <= len) pre[it] = *(const u32x4*)(zb + ((size_t)q.row0 + tg) * ZC + 256 + pc); } }
}
__device__ __forceinline__ void rwkv_unit(PRef P, const Ctx& c, int layer, int s, int h) {
    const SeqInfo q = seq_info(s);
    const bf16_t* zb = (const bf16_t*)(P.ws + WS_Z);
    bf16_t* yabc = (bf16_t*)(P.ws + WS_H);
    float* sm = (float*)c.lds;
    float* XR = sm; float* XK = sm + 2048; float* XV = sm + 4096; float* DEC = sm + 6144; float* AIC = sm + 8192; float* GG = sm + 10240; float* KKn = sm + 12288; float* YO = sm + 14336;
    float* BON = sm + 16384;
    bf16_t* LW = (bf16_t*)(sm + 16448);
    bf16_t* LA = LW + 1024;
    bf16_t* LG = LA + 1024;
    float* RAW = sm + 18496;
    float* MU = sm + 29056;
    const int tid = c.tid, lane = c.lane, wave = c.wave;
    const float* mu = P.in[I_MU] + layer * RWC;
    const float* shiftst = q.prompt ? nullptr : P.in[I_SSH] + ((size_t)layer * 128 + q.n) * RWC;
    const int mt = wave >> 2, ntile = wave & 3, quad = lane >> 4, l15 = lane & 15;
    const int cB = h * 64 + ntile * 16 + l15;
    bf16x8 bW, bA, bG0, bG1;
    {
        const float* w2 = P.in[I_W2] + (size_t)layer * 32 * 512; const float* a2 = P.in[I_A2] + (size_t)layer * 32 * 512; const float* g2 = P.in[I_G2] + (size_t)layer * 64 * 512;
#pragma unroll
        for (int j = 0; j < 8; ++j) { bW[j] = (short)f2bf(w2[(quad * 8 + j) * 512 + cB]); bA[j] = (short)f2bf(a2[(quad * 8 + j) * 512 + cB]);
            bG0[j] = (short)f2bf(g2[(quad * 8 + j) * 512 + cB]); bG1[j] = (short)f2bf(g2[(32 + quad * 8 + j) * 512 + cB]); }
    }
    const float w0c = P.in[I_W0][layer * 512 + cB], a0c = P.in[I_A0][layer * 512 + cB];
    const int cl = h * 64 + lane;
    const float kkc = P.in[I_KK][layer * 512 + cl], kac = P.in[I_KA][layer * 512 + cl], rkc = P.in[I_RK][layer * 512 + cl], lnw = P.in[I_LNW][layer * 512 + cl], lnb = P.in[I_LNB][layer * 512 + cl];
    const int v = tid >> 3, sub = tid & 7;
    float st[8];
    if (q.prompt) {
#pragma unroll
        for (int j = 0; j < 8; ++j) st[j] = 0.f;
    } else {
        const float* sp = P.in[I_SRW] + (((size_t)layer * 128 + q.n) * 8 + h) * 4096 + v * 64 + sub * 8;
        const f32x4 a = *(const f32x4*)sp, b = *(const f32x4*)(sp + 4);
        st[0] = a[0]; st[1] = a[1]; st[2] = a[2]; st[3] = a[3]; st[4] = b[0]; st[5] = b[1]; st[6] = b[2]; st[7] = b[3];
    }
    u32x4 pre[3]; rwkv_prefetch(zb, q, h, 0, tid, pre);
    if (tid < 320) { const int pcm = tid < 192 ? (tid >> 6) * 512 + h * 64 + (tid & 63) : 1536 + (tid - 192); MU[tid] = mu[pcm]; }
    for (int t0 = 0; t0 < q.L; t0 += 32) {
        const int len = (q.L - t0) < 32 ? (q.L - t0) : 32;
#pragma unroll
        for (int it = 0; it < 3; ++it) { const int idx = tid + it * NTHREADS;
            if (idx < 33 * 40) {
                const int rr = idx / 40, vec = idx - rr * 40;
                const int pc = vec < 24 ? (vec >> 3) * 512 + h * 64 + (vec & 7) * 8 : 1536 + (vec - 24) * 8;
                const int tg = t0 - 1 + rr;
                f32x4 x0 = {0.f, 0.f, 0.f, 0.f}, x1 = x0;
                if (tg < 0) { if (!q.prompt) { x0 = *(const f32x4*)(shiftst + pc); x1 = *(const f32x4*)(shiftst + pc + 4); } }
                else if (rr <= len) { const u32x4 w = pre[it];
                    x0 = (f32x4){bflo(w.x), bfhi(w.x), bflo(w.y), bfhi(w.y)}; x1 = (f32x4){bflo(w.z), bfhi(w.z), bflo(w.w), bfhi(w.w)}; }
                *(f32x4*)(RAW + rr * 320 + vec * 8) = x0; *(f32x4*)(RAW + rr * 320 + vec * 8 + 4) = x1; } }
        __syncthreads();
        rwkv_prefetch(zb, q, h, t0 + 32, tid, pre);
        for (int idx = tid; idx < 32 * 48; idx += NTHREADS) {
            const int t = idx / 48, cc = (idx - t * 48) * 4;
            f32x4 xm = {0.f, 0.f, 0.f, 0.f};
            if (t < len) { const f32x4 p = *(const f32x4*)(RAW + (t + 1) * 320 + cc), pp = *(const f32x4*)(RAW + t * 320 + cc), m = *(const f32x4*)(MU + cc); xm = p + (pp - p) * m; }
            float* dst = cc < 64 ? XR + t * 64 + cc : cc < 128 ? XK + t * 64 + cc - 64 : XV + t * 64 + cc - 128;
            *(f32x4*)dst = xm;
        }
        for (int idx = tid; idx < 32 * 128; idx += NTHREADS) {
            const int t = idx >> 7, j = idx & 127, cc = 192 + j;
            float x = 0.f;
            if (t < len) { const float p = RAW[(t + 1) * 320 + cc], pp = RAW[t * 320 + cc]; x = p + (pp - p) * MU[cc]; }
            const float sg = fsigmoid(j < 32 ? 2.f * x : x);
            const float val = j < 32 ? 2.f * sg - 1.f : (j < 64 ? x : sg);
            bf16_t* dst = j < 32 ? LW + t * 32 + j : (j < 64 ? LA + t * 32 + j - 32 : LG + t * 64 + j - 64);
            *dst = f2bf(val);
        }
        __syncthreads();
        {
            const bf16x8 aW = *(const bf16x8*)(LW + (mt * 16 + l15) * 32 + quad * 8), aA = *(const bf16x8*)(LA + (mt * 16 + l15) * 32 + quad * 8);
            const bf16x8 aG0 = *(const bf16x8*)(LG + (mt * 16 + l15) * 64 + quad * 8), aG1 = *(const bf16x8*)(LG + (mt * 16 + l15) * 64 + 32 + quad * 8);
            const f32x4 z4 = {0.f, 0.f, 0.f, 0.f};
            f32x4 cw = __builtin_amdgcn_mfma_f32_16x16x32_bf16(aW, bW, z4, 0, 0, 0);
            f32x4 ca = __builtin_amdgcn_mfma_f32_16x16x32_bf16(aA, bA, z4, 0, 0, 0);
            f32x4 cg_ = __builtin_amdgcn_mfma_f32_16x16x32_bf16(aG0, bG0, z4, 0, 0, 0);
            cg_ = __builtin_amdgcn_mfma_f32_16x16x32_bf16(aG1, bG1, cg_, 0, 0, 0);
#pragma unroll
            for (int j = 0; j < 4; ++j) { const int t = mt * 16 + quad * 4 + j, cc = ntile * 16 + l15;
                const float wv = w0c + cw[j]; const float nx = -wv; const float sp = (nx > 0.f ? nx : 0.f) + __logf(1.f + __expf(-fabsf(nx)));
                DEC[t * 64 + cc] = __expf(-__expf(-sp - 0.5f));
                AIC[t * 64 + cc] = fsigmoid(a0c + ca[j]);
                GG[t * 64 + cc] = cg_[j]; }
        }
        __syncthreads();
#pragma unroll
        for (int i = 0; i < 4; ++i) { const int t = wave + 8 * i; const int o = t * 64 + lane;
            const float k = XK[o], a = AIC[o], r = XR[o];
            const float kkv = k * kkc; const float ssq = wave_sum(kkv * kkv); const float kk = kkv * rsqrtf(fmaxf(ssq, 1e-24f));
            const float kp = k * (1.f + (a - 1.f) * kac);
            const float bon = wave_sum(r * kp * rkc);
            XK[o] = kp; KKn[o] = kk; AIC[o] = kk * a; if (lane == 0) BON[t] = bon; }
        __syncthreads();
        {
            f32x2v s2[4] = {{st[0], st[1]}, {st[2], st[3]}, {st[4], st[5]}, {st[6], st[7]}};
            for (int t = 0; t < len; ++t) {
                const int o = t * 64 + sub * 8;
                const f32x4 r0 = *(const f32x4*)(XR + o), r1 = *(const f32x4*)(XR + o + 4), w0 = *(const f32x4*)(DEC + o), w1 = *(const f32x4*)(DEC + o + 4), k0 = *(const f32x4*)(XK + o), k1 = *(const f32x4*)(XK + o + 4);
                const f32x4 n0 = *(const f32x4*)(KKn + o), n1 = *(const f32x4*)(KKn + o + 4), b0 = *(const f32x4*)(AIC + o), b1 = *(const f32x4*)(AIC + o + 4);
                const float vv = XV[t * 64 + v];
                f32x2v acc = s2[0] * n0.xy; acc = s2[1] * n0.zw + acc; acc = s2[2] * n1.xy + acc; acc = s2[3] * n1.zw + acc;
                const float sa = -red8(acc.x + acc.y);
                const f32x2v sa2 = {sa, sa}, vv2 = {vv, vv};
                s2[0] = s2[0] * w0.xy + (sa2 * b0.xy + vv2 * k0.xy); s2[1] = s2[1] * w0.zw + (sa2 * b0.zw + vv2 * k0.zw);
                s2[2] = s2[2] * w1.xy + (sa2 * b1.xy + vv2 * k1.xy); s2[3] = s2[3] * w1.zw + (sa2 * b1.zw + vv2 * k1.zw);
                f32x2v ya = s2[0] * r0.xy; ya = s2[1] * r0.zw + ya; ya = s2[2] * r1.xy + ya; ya = s2[3] * r1.zw + ya;
                const float y = red8(ya.x + ya.y);
                if (sub == 0) YO[t * 64 + v] = y;
            }
            st[0] = s2[0].x; st[1] = s2[0].y; st[2] = s2[1].x; st[3] = s2[1].y; st[4] = s2[2].x; st[5] = s2[2].y; st[6] = s2[3].x; st[7] = s2[3].y;
        }
        __syncthreads();
#pragma unroll
        for (int i = 0; i < 4; ++i) { const int t = wave + 8 * i; if (t < len) { const int o = t * 64 + lane;
            const float y = YO[o]; const float mean = wave_sum(y) * (1.f / 64.f); const float d = y - mean; const float var = wave_sum(d * d) * (1.f / 64.f);
            const float yn = d * rsqrtf(var + 64e-5f);
            const float res = (yn * lnw + lnb + BON[t] * XV[o]) * GG[o];
            yabc[((size_t)q.row0 + t0 + t) * 1024 + 256 + h * 64 + lane] = f2bf(res); } }
        __syncthreads();
    }
    float* so = q.prompt ? P.out + O_RWP + (((size_t)layer * 8 + q.n) * 8 + h) * 4096 : P.out + O_RWS + (((size_t)layer * 128 + q.n) * 8 + h) * 4096;
    *(f32x4*)(so + v * 64 + sub * 8) = (f32x4){st[0], st[1], st[2], st[3]}; *(f32x4*)(so + v * 64 + sub * 8 + 4) = (f32x4){st[4], st[5], st[6], st[7]};
}

__device__ __forceinline__ void hgrn_unit(PRef P, const Ctx& c, int layer, int s, int h) {
    const SeqInfo q = seq_info(s);
    const bf16_t* zb = (const bf16_t*)(P.ws + WS_Z);
    bf16_t* yabc = (bf16_t*)(P.ws + WS_H);
    float* sm = (float*)c.lds;
    float* FQ = sm; float* FFg = sm + 2048; float* FK = sm + 4096; float* FI = sm + 6144; float* FO = sm + 8192; float* OO = sm + 10240;
    const int tid = c.tid, lane = c.lane, wave = c.wave;
    const int vc = tid >> 3, sub = tid & 7;
    float st[8];
    if (q.prompt) {
#pragma unroll
        for (int j = 0; j < 8; ++j) st[j] = 0.f;
    } else {
        const float* sp = P.in[I_SHG] + (((size_t)layer * 128 + q.n) * 4 + h) * 4096;
#pragma unroll
        for (int j = 0; j < 8; ++j) st[j] = sp[(sub * 8 + j) * 64 + vc];
    }
    const float hn = P.in[I_HNORM][layer * 256 + h * 64 + lane];
    for (int t0 = 0; t0 < q.L; t0 += 32) {
        const int len = (q.L - t0) < 32 ? (q.L - t0) : 32;
        for (int idx = tid; idx < 1024; idx += NTHREADS) {
            const int t = idx >> 5, arr = (idx >> 3) & 3, vec = idx & 7; const int c0 = vec * 8;
            float xv[8];
            if (t < len) { const u32x4 w = *(const u32x4*)(zb + ((size_t)q.row0 + t0 + t) * ZC + 1920 + arr * 256 + h * 64 + c0);
                xv[0] = bflo(w.x); xv[1] = bfhi(w.x); xv[2] = bflo(w.y); xv[3] = bfhi(w.y); xv[4] = bflo(w.z); xv[5] = bfhi(w.z); xv[6] = bflo(w.w); xv[7] = bfhi(w.w); }
            else {
#pragma unroll
                for (int j = 0; j < 8; ++j) xv[j] = 0.f; }
            const int o = t * 64 + c0;
            if (arr == 0) {
#pragma unroll
                for (int j = 0; j < 8; ++j) FQ[o + j] = xv[j] * fsigmoid(xv[j]); }
            else if (arr == 1) {
#pragma unroll
                for (int j = 0; j < 8; ++j) { float lower = 0.f;
                    if (layer == 1) { const float l0 = P.in[I_HLB][h * 64 + c0 + j], l1 = P.in[I_HLB][256 + h * 64 + c0 + j]; lower = fsigmoid(l1 - l0); }
                    const float fg = lower + (1.f - lower) * fsigmoid(xv[j]);
                    FFg[o + j] = fmaxf(fg, 1e-30f); FK[o + j] = 1.f - fg; } }
            else if (arr == 2) {
#pragma unroll
                for (int j = 0; j < 8; ++j) FI[o + j] = xv[j]; }
            else {
#pragma unroll
                for (int j = 0; j < 8; ++j) FO[o + j] = fsigmoid(xv[j]); }
        }
        __syncthreads();
        {
            f32x2v s2[4] = {{st[0], st[1]}, {st[2], st[3]}, {st[4], st[5]}, {st[6], st[7]}};
            for (int t = 0; t < len; ++t) {
                const int o8 = t * 64 + sub * 8;
                const f32x4 q0 = *(const f32x4*)(FQ + o8), q1 = *(const f32x4*)(FQ + o8 + 4), f0 = *(const f32x4*)(FFg + o8), f1 = *(const f32x4*)(FFg + o8 + 4), k0 = *(const f32x4*)(FK + o8), k1 = *(const f32x4*)(FK + o8 + 4);
                const float iv = FI[t * 64 + vc]; const f32x2v iv2 = {iv, iv};
                s2[0] = f0.xy * s2[0] + k0.xy * iv2; s2[1] = f0.zw * s2[1] + k0.zw * iv2; s2[2] = f1.xy * s2[2] + k1.xy * iv2; s2[3] = f1.zw * s2[3] + k1.zw * iv2;
                f32x2v oa = s2[0] * q0.xy; oa = s2[1] * q0.zw + oa; oa = s2[2] * q1.xy + oa; oa = s2[3] * q1.zw + oa;
                const float o = red8(oa.x + oa.y);
                if (sub == 0) OO[t * 64 + vc] = o;
            }
            st[0] = s2[0].x; st[1] = s2[0].y; st[2] = s2[1].x; st[3] = s2[1].y; st[4] = s2[2].x; st[5] = s2[2].y; st[6] = s2[3].x; st[7] = s2[3].y;
        }
        __syncthreads();
#pragma unroll
        for (int i = 0; i < 4; ++i) { const int t = wave + 8 * i; if (t < len) { const int o = t * 64 + lane;
            const float ov = OO[o]; const float ms = wave_sum(ov * ov) * (1.f / 64.f);
            yabc[((size_t)q.row0 + t0 + t) * 1024 + 768 + h * 64 + lane] = f2bf(ov * rsqrtf(ms + 1e-6f) * hn * FO[o]); } }
        __syncthreads();
    }
    float* so = q.prompt ? P.out + O_HGP + (((size_t)layer * 8 + q.n) * 4 + h) * 4096 : P.out + O_HGS + (((size_t)layer * 128 + q.n) * 4 + h) * 4096;
#pragma unroll
    for (int j = 0; j < 8; ++j) so[(sub * 8 + j) * 64 + vc] = st[j];
}

struct S5Const { float bbr[16], bbi[16], cm[32], ar, ai, dsk; };
__device__ __forceinline__ void s5_const(PRef P, int layer, int g, int lane, S5Const& k) {
    const int p = lane;
    const float lr = P.in[I_LRE][(layer * 16 + g) * 64 + p], li = P.in[I_LIM][(layer * 16 + g) * 64 + p];
    const float dt = expf(P.in[I_LDT][layer * 16 + g]);
    const float mag = expf(lr * dt); const float ar = mag * cosf(li * dt), ai = mag * sinf(li * dt);
    const float den = lr * lr + li * li;
    const float zr = ((ar - 1.f) * lr + ai * li) / den, zi = (ai * lr - (ar - 1.f) * li) / den;
    const float* bre = P.in[I_BRE] + ((size_t)(layer * 16 + g) * 64 + p) * 16; const float* bim = P.in[I_BIM] + ((size_t)(layer * 16 + g) * 64 + p) * 16;
#pragma unroll
    for (int cc = 0; cc < 16; ++cc) { const float br = bre[cc], bi = bim[cc]; k.bbr[cc] = zr * br - zi * bi; k.bbi[cc] = zr * bi + zi * br; }
    const int cch = lane & 15, quad = lane >> 4;
    const float* cre = P.in[I_CRE] + ((size_t)(layer * 16 + g) * 16 + cch) * 64; const float* cim = P.in[I_CIM] + ((size_t)(layer * 16 + g) * 16 + cch) * 64;
#pragma unroll
    for (int kk = 0; kk < 32; ++kk) { const int qq = 4 * kk + quad; k.cm[kk] = qq < 64 ? cre[qq] : -cim[qq - 64]; }
    k.ar = ar; k.ai = ai; k.dsk = P.in[I_S5D][layer * 256 + g * 16 + cch];
}
template <bool FULL>
__device__ __forceinline__ void s5_chunk(PRef P, const S5Const& k, int g, int rowbase, int len, float& sr, float& si, float* wscr, int lane) {
    const bf16_t* zb = (const bf16_t*)(P.ws + WS_Z);
    bf16_t* ypre = (bf16_t*)(P.ws + WS_YPRE);
    float* U = wscr; float* Sm = wscr + 1024;
    LDS_FENCE();
    if (lane < len) { const u32x4 a = *(const u32x4*)(zb + (size_t)(rowbase + lane) * ZC + g * 16), b = *(const u32x4*)(zb + (size_t)(rowbase + lane) * ZC + g * 16 + 8);
        float* up = U + lane * 16;
        *(f32x4*)(up) = (f32x4){bflo(a.x), bfhi(a.x), bflo(a.y), bfhi(a.y)}; *(f32x4*)(up + 4) = (f32x4){bflo(a.z), bfhi(a.z), bflo(a.w), bfhi(a.w)};
        *(f32x4*)(up + 8) = (f32x4){bflo(b.x), bfhi(b.x), bflo(b.y), bfhi(b.y)}; *(f32x4*)(up + 12) = (f32x4){bflo(b.z), bfhi(b.z), bflo(b.w), bfhi(b.w)}; }
    LDS_FENCE();
    const int nsub = (len + 15) >> 4;
    for (int sb = 0; sb < nsub; ++sb) {
#pragma unroll 4
        for (int tt = 0; tt < 16; ++tt) {
            const int t = sb * 16 + tt;
            if (t < len) {
                const f32x4* up = (const f32x4*)(U + t * 16); const f32x4 u0 = up[0], u1 = up[1], u2 = up[2], u3 = up[3];
                float er = 0.f, ei = 0.f;
#pragma unroll
                for (int j = 0; j < 4; ++j) { er += k.bbr[j] * u0[j]; ei += k.bbi[j] * u0[j]; }
#pragma unroll
                for (int j = 0; j < 4; ++j) { er += k.bbr[4 + j] * u1[j]; ei += k.bbi[4 + j] * u1[j]; }
#pragma unroll
                for (int j = 0; j < 4; ++j) { er += k.bbr[8 + j] * u2[j]; ei += k.bbi[8 + j] * u2[j]; }
#pragma unroll
                for (int j = 0; j < 4; ++j) { er += k.bbr[12 + j] * u3[j]; ei += k.bbi[12 + j] * u3[j]; }
                const float nr = k.ar * sr - k.ai * si + er, ni = k.ar * si + k.ai * sr + ei;
                sr = nr; si = ni;
                if (FULL) { Sm[tt * 132 + lane] = sr; Sm[tt * 132 + 64 + lane] = si; }
            } else if (FULL) { Sm[tt * 132 + lane] = 0.f; Sm[tt * 132 + 64 + lane] = 0.f; }
        }
        if (FULL) {
            LDS_FENCE();
            const int row = lane & 15, quad = lane >> 4;
            f32x4 acc = {0.f, 0.f, 0.f, 0.f};
#pragma unroll
            for (int kk = 0; kk < 32; ++kk) acc = __builtin_amdgcn_mfma_f32_16x16x4f32(Sm[row * 132 + 4 * kk + quad], k.cm[kk], acc, 0, 0, 0);
#pragma unroll
            for (int j = 0; j < 4; ++j) { const int t = sb * 16 + quad * 4 + j;
                if (t < len) { const float y = acc[j] + k.dsk * U[t * 16 + row]; ypre[(size_t)(rowbase + t) * 256 + g * 16 + row] = f2bf(gelu_tanh(y)); } }
            LDS_FENCE();
        }
    }
}
__device__ __forceinline__ void cmul_acc(float ar, float ai, float& sr, float& si, float er, float ei) { const float nr = ar * sr - ai * si + er, ni = ar * si + ai * sr + ei; sr = nr; si = ni; }
__device__ __forceinline__ void s5_prompt_unit(PRef P, const Ctx& c, int layer, int n, int g) {
    S5Const k; s5_const(P, layer, g, c.lane, k);
    float* sm = (float*)c.lds;
    float* END = sm;
    float* wscr = sm + 1024 + c.wave * (1024 + 16 * 132);
    float a64r = k.ar, a64i = k.ai;
#pragma unroll
    for (int i = 0; i < 6; ++i) { const float r = a64r * a64r - a64i * a64i; float im = a64r * a64i; im += im; a64r = r; a64i = im; }
    float cr = 0.f, ci = 0.f;
    for (int round = 0; round < 4; ++round) {
        const int rowbase = n * 2048 + (round * 8 + c.wave) * 64;
        float lr_ = 0.f, li_ = 0.f;
        s5_chunk<false>(P, k, g, rowbase, 64, lr_, li_, wscr, c.lane);
        END[c.wave * 128 + c.lane] = lr_; END[c.wave * 128 + 64 + c.lane] = li_;
        __syncthreads();
        float sr = cr, si = ci, ar_ = cr, ai_ = ci;
        for (int w = 0; w < 8; ++w) { const float er = END[w * 128 + c.lane], ei = END[w * 128 + 64 + c.lane];
            if (w < c.wave) cmul_acc(a64r, a64i, sr, si, er, ei);
            cmul_acc(a64r, a64i, ar_, ai_, er, ei); }
        cr = ar_; ci = ai_;
        __syncthreads();
        s5_chunk<true>(P, k, g, rowbase, 64, sr, si, wscr, c.lane);
    }
    if (c.wave == 0) { float* o = P.out + O_S5P + (((size_t)layer * 8 + n) * 16 + g) * 128 + c.lane * 2; o[0] = cr; o[1] = ci; }
    __syncthreads();
}
__device__ __forceinline__ void s5_sample_wave(PRef P, const Ctx& c, int layer, int n, int g) {
    S5Const k; s5_const(P, layer, g, c.lane, k);
    float* wscr = (float*)c.lds + 1024 + c.wave * (1024 + 16 * 132);
    const float* sp = P.in[I_SS5] + (((size_t)layer * 128 + n) * 16 + g) * 128 + c.lane * 2;
    float sr = sp[0], si = sp[1];
    s5_chunk<true>(P, k, g, TP + n * 4, 4, sr, si, wscr, c.lane);
    float* o = P.out + O_S5S + (((size_t)layer * 128 + n) * 16 + g) * 128 + c.lane * 2; o[0] = sr; o[1] = si;
}

__device__ __forceinline__ void phase_scan(PRef P, const Ctx& c, int layer) {
    for (int u = c.b; u < 224; u += c.G) {
        if (u < 64) rwkv_unit(P, c, layer, u >> 3, u & 7);
        else if (u < 96) hgrn_unit(P, c, layer, (u - 64) >> 2, (u - 64) & 3);
        else s5_prompt_unit(P, c, layer, (u - 96) >> 4, (u - 96) & 15);
    }
    if (c.G == 256 && c.b >= 224) { Ctx cc = c; cc.b = c.b - 224; cc.G = 32; convert_layer_weights(P, cc, layer, 2); __syncthreads(); }
    const int nb = c.G > 96 ? c.G - 96 : c.G, sb = c.G > 96 ? c.b - 96 : c.b;
    if (sb >= 0) for (int j = sb; j < 1792; j += nb) {
        if (j < 1024) rwkv_unit(P, c, layer, 8 + (j >> 3), j & 7);
        else if (j < 1536) hgrn_unit(P, c, layer, 8 + ((j - 1024) >> 2), (j - 1024) & 3);
        else { const int w = (j - 1536) * 8 + c.wave; s5_sample_wave(P, c, layer, w >> 4, w & 15); __syncthreads(); }
    }
}

__device__ __forceinline__ void unpack8(const u32x4 w, float* x) { x[0] = bflo(w.x); x[1] = bfhi(w.x); x[2] = bflo(w.y); x[3] = bfhi(w.y); x[4] = bflo(w.z); x[5] = bfhi(w.z); x[6] = bflo(w.w); x[7] = bfhi(w.w); }
__device__ __forceinline__ void phase_conv(PRef P, const Ctx& c, int layer) {
    bf16_t* up = (bf16_t*)(P.ws + WS_UP); const bf16_t* halo = (const bf16_t*)(P.ws + WS_HALO);
    const float* cw = P.in[I_CW] + (size_t)layer * 3 * FF2; const float* cb = P.in[I_CB] + (size_t)layer * FF2;
    const int cgp = c.tid & 31, seg = c.tid >> 5;
    for (int item = c.b; item < 66 * 11; item += c.G) {
        const int pm = item / 11, strip = item - pm * 11; const int c0 = strip * 256 + cgp * 8;
        const int r0 = pm * 256 + seg * 16;
        float wa[3][8], wb[3][8], ba[8], bb[8];
#pragma unroll
        for (int j = 0; j < 3; ++j)
#pragma unroll
            for (int e = 0; e < 8; ++e) { wa[j][e] = cw[j * FF2 + c0 + e]; wb[j][e] = cw[j * FF2 + FF + c0 + e]; }
#pragma unroll
        for (int e = 0; e < 8; ++e) { ba[e] = cb[c0 + e]; bb[e] = cb[FF + c0 + e]; }
        float p2a[8], p2b[8], p1a[8], p1b[8];
        {
            const int tl = r0 < TP ? (r0 & 2047) : ((r0 - TP) & 3);
            if (tl == 0) {
#pragma unroll
                for (int e = 0; e < 8; ++e) { p2a[e] = p2b[e] = p1a[e] = p1b[e] = 0.f; }
            } else {
                const bf16_t* s2 = seg > 0 ? up + (size_t)(r0 - 2) * FF2 : halo + ((size_t)(pm - 1) * 2 + 0) * FF2;
                const bf16_t* s1 = seg > 0 ? up + (size_t)(r0 - 1) * FF2 : halo + ((size_t)(pm - 1) * 2 + 1) * FF2;
                unpack8(*(const u32x4*)(s2 + c0), p2a); unpack8(*(const u32x4*)(s2 + FF + c0), p2b); unpack8(*(const u32x4*)(s1 + c0), p1a); unpack8(*(const u32x4*)(s1 + FF + c0), p1b);
            }
        }
        __syncthreads();
        for (int rb = 0; rb < 4; ++rb) {
            u32x4 ra[4], rbv[4];
#pragma unroll
            for (int i = 0; i < 4; ++i) { const size_t row = (size_t)r0 + rb * 4 + i; ra[i] = *(const u32x4*)(up + row * FF2 + c0); rbv[i] = *(const u32x4*)(up + row * FF2 + FF + c0); }
#pragma unroll
            for (int i = 0; i < 4; ++i) { const int row = r0 + rb * 4 + i;
                const int tl = row < TP ? (row & 2047) : ((row - TP) & 3);
                if (tl == 0) {
                    if (row < TP) {
#pragma unroll
                        for (int e = 0; e < 8; ++e) { p2a[e] = p2b[e] = p1a[e] = p1b[e] = 0.f; }
                    } else { const float* sp = P.in[I_SCV] + ((size_t)layer * 128 + ((row - TP) >> 2)) * 2 * FF2;
#pragma unroll
                        for (int e = 0; e < 8; ++e) { p2a[e] = sp[c0 + e]; p2b[e] = sp[FF + c0 + e]; p1a[e] = sp[FF2 + c0 + e]; p1b[e] = sp[FF2 + FF + c0 + e]; } }
                }
                float ca[8], cbv[8], o[8]; unpack8(ra[i], ca); unpack8(rbv[i], cbv);
#pragma unroll
                for (int e = 0; e < 8; ++e) { const float xa = ba[e] + wa[0][e] * p2a[e] + wa[1][e] * p1a[e] + wa[2][e] * ca[e]; const float xb = bb[e] + wb[0][e] * p2b[e] + wb[1][e] * p1b[e] + wb[2][e] * cbv[e];
                    o[e] = gelu_tanh(xa) * xb; p2a[e] = p1a[e]; p2b[e] = p1b[e]; p1a[e] = ca[e]; p1b[e] = cbv[e]; }
                u32x4 w; w.x = cvt_pk_bf16(o[0], o[1]); w.y = cvt_pk_bf16(o[2], o[3]); w.z = cvt_pk_bf16(o[4], o[5]); w.w = cvt_pk_bf16(o[6], o[7]);
                *(u32x4*)(up + (size_t)row * FF2 + c0) = w; }
        }
        __syncthreads();
    }
}

#define XB_TMO      128
#define XB_XCNT(j)  (256  + 64 * (j))
#define XB_XSUB(j)  (1280 + 64 * (j))
#define XB_XGEN(j)  (2304 + 64 * (j))
#define XB_TOP      3328
#define XB_TOPGEN   3392
#define XCD_BAR_WORDS 3456
#define XB_SPIN_CAP (1u << 18)

__device__ __forceinline__ unsigned xb_ld(unsigned* p)              { return __hip_atomic_load(p, __ATOMIC_RELAXED, __HIP_MEMORY_SCOPE_AGENT); }
__device__ __forceinline__ unsigned xb_add(unsigned* p, unsigned v) { return __hip_atomic_fetch_add(p, v, __ATOMIC_RELAXED, __HIP_MEMORY_SCOPE_AGENT); }
__device__ __forceinline__ unsigned xb_xcc_id() { return (unsigned)__builtin_amdgcn_s_getreg((3 << 11) | 20) & 0xFu; }
#define XB_SPIN(cond, bar) do { unsigned _sp = 0; while (cond) { __builtin_amdgcn_s_sleep(1); \
    if ((++_sp & 255u) == 0u) { if (xb_ld(&(bar)[XB_TMO])) break; if (_sp > XB_SPIN_CAP) { atomicAdd(&(bar)[XB_TMO], 1u); break; } } } } while (0)

struct XcdBarrier {
    unsigned* bar; unsigned x;
    volatile LAS unsigned* st;
};

__device__ __forceinline__ XcdBarrier xcd_barrier_post(unsigned* bar, volatile LAS unsigned* st) {
    XcdBarrier b; b.bar = bar; b.x = xb_xcc_id(); b.st = st;
    if (threadIdx.x == 0) (void)xb_add(&bar[XB_XCNT(b.x)], 1u);
    return b;
}
__device__ __forceinline__ void xcd_barrier_complete(unsigned* bar, unsigned x, unsigned& nloc, unsigned& nx) {
    const unsigned G = gridDim.x * gridDim.y * gridDim.z;
    unsigned sum, cnt, mine, sp = 0u;
    for (;;) {
        sum = 0u; cnt = 0u; mine = 0u;
#pragma unroll
        for (unsigned j = 0; j < 16; ++j) { const unsigned c = xb_ld(&bar[XB_XCNT(j)]); sum += c; cnt += (c > 0u) ? 1u : 0u; mine = (j == x) ? c : mine; }
        if (sum == G) break;
        __builtin_amdgcn_s_sleep(1);
        if ((++sp & 255u) == 0u) { if (xb_ld(&bar[XB_TMO])) break; if (sp > XB_SPIN_CAP) { atomicAdd(&bar[XB_TMO], 1u); break; } }
    }
    nloc = mine > 0u ? mine : 1u; nx = cnt > 0u ? cnt : 1u;
}

__device__ __forceinline__ void xcd_barrier(const XcdBarrier& b) {
    asm volatile("s_waitcnt vmcnt(0)" ::: "memory");
    __syncthreads();
    if (threadIdx.x == 0) {
        unsigned* bar = b.bar;
        __builtin_amdgcn_s_waitcnt(0);
        unsigned nloc = b.st[0], nx = b.st[1];
        if (nloc == 0u) { xcd_barrier_complete(bar, b.x, nloc, nx); b.st[0] = nloc; b.st[1] = nx; }
        const unsigned old = xb_add(&bar[XB_XSUB(b.x)], 1u);
        const unsigned gen = old / nloc;
        if (old + 1u == (gen + 1u) * nloc) {
            __builtin_amdgcn_fence(__ATOMIC_RELEASE, "agent");
            asm volatile("s_waitcnt vmcnt(0)" ::: "memory");
            const unsigned og = xb_add(&bar[XB_TOP], 1u);
            const unsigned tg = og / nx;
            if (og + 1u == (tg + 1u) * nx) xb_add(&bar[XB_TOPGEN], 1u);
            else XB_SPIN(xb_ld(&bar[XB_TOPGEN]) == tg, bar);
            __builtin_amdgcn_fence(__ATOMIC_ACQUIRE, "agent");
            xb_add(&bar[XB_XGEN(b.x)], 1u);
            asm volatile("s_waitcnt vmcnt(0)" ::: "memory");
        } else {
            XB_SPIN(xb_ld(&bar[XB_XGEN(b.x)]) == gen, bar);
            __builtin_amdgcn_fence(__ATOMIC_ACQUIRE, "agent");
            asm volatile("s_waitcnt vmcnt(0)" ::: "memory");
        }
    }
    __syncthreads();
}
constexpr int N_PHASES = 2 + 10 * 2 + 1;
__device__ __forceinline__ void run_phase(PRef P, const Ctx& c, int ph) {
    unsigned char* ws = P.ws;
    float* mod = (float*)(ws + WS_MOD);
    bf16_t* H = (bf16_t*)(ws + WS_H);
    bf16_t* zb = (bf16_t*)(ws + WS_Z); bf16_t* gb = (bf16_t*)(ws + WS_G); bf16_t* up = (bf16_t*)(ws + WS_UP);
    if (ph == 0) { phase_start(P, c); return; }
    if (ph == 1) { EpiAda E{mod, P.in[I_BADA]}; run_gemm(c, (const bf16_t*)(ws + WS_AADA), 1024, (const bf16_t*)(ws + WS_WADA), 256, 12288, 1024, E); return; }
    if (ph == N_PHASES - 1) { phase_final_norm(P, c); return; }
    const int layer = (ph - 2) / 10, sp = (ph - 2) % 10;
    switch (sp) {
    case 0: phase_norm(P, c, layer, 0, layer == 0); if (layer > 0) convert_layer_weights(P, c, layer, c.G == 256 ? 1 : 0); break;
    case 1: { EpiZ E{zb, gb, P.out, layer}; run_gemm(c, H, 1024, (const bf16_t*)(ws + WS_WIN), T, INP, 1024, E); } break;
    case 2: phase_scan(P, c, layer); break;
    case 3: { EpiGlu E{(const bf16_t*)(ws + WS_YPRE), H, P.in[I_BGLU] + layer * 256}; run_gemm(c, (const bf16_t*)(ws + WS_YPRE), 256, (const bf16_t*)(ws + WS_WGLU), T, 256, 256, E); } break;
    case 4: { EpiLift E0{gb, 0}; run_gemm(c, H, 1024, (const bf16_t*)(ws + WS_LA), T, 1024, 256, E0);
              EpiLift E1{gb, 1}; run_gemm(c, H + 256, 1024, (const bf16_t*)(ws + WS_LB), T, 1024, 512, E1);
              EpiLift E2{gb, 2}; run_gemm(c, H + 768, 1024, (const bf16_t*)(ws + WS_LC), T, 1024, 256, E2); } break;
    case 5: { EpiRes E{P.out, mod + (size_t)layer * NSEQ * 6144 + 2 * 1024}; run_gemm(c, gb, GC, (const bf16_t*)(ws + WS_WOUT3), T, 1024, 1024, E); } break;
    case 6: phase_norm(P, c, layer, 1, false); break;
    case 7: { EpiUp E{up, (bf16_t*)(ws + WS_HALO), P.out, layer}; run_gemm(c, H, 1024, (const bf16_t*)(ws + WS_WUP), T, FF2, 1024, E); } break;
    case 8: phase_conv(P, c, layer); break;
    case 9: { EpiRes E{P.out, mod + (size_t)layer * NSEQ * 6144 + 5 * 1024}; run_gemm(c, up, FF2, (const bf16_t*)(ws + WS_WDN), T, 1024, FF, E); } break;
    }
}

__global__ void __launch_bounds__(NTHREADS, 2) fwd_kernel(Params P, int ph_lo, int ph_hi) {
    extern __shared__ __attribute__((aligned(16))) unsigned char shm[];
    volatile LAS unsigned* bst = (volatile LAS unsigned*)((LAS unsigned char*)shm + (LDS_BYTES - 8));
    if (threadIdx.x == 0) { bst[0] = 0u; bst[1] = 0u; }
    __syncthreads();
    const XcdBarrier gbar = xcd_barrier_post((unsigned*)(P.ws + WS_BAR), bst);
    const int wave_s = __builtin_amdgcn_readfirstlane(threadIdx.x >> 6);
    for (int ph = ph_lo; ph < ph_hi; ++ph) {
        int lane_; asm volatile("v_mbcnt_lo_u32_b32 %0, -1, 0\n\tv_mbcnt_hi_u32_b32 %0, -1, %0" : "=v"(lane_));
        int tid_ = wave_s * 64 + lane_; asm volatile("" : "+v"(tid_));
        int bid_ = blockIdx.x; asm volatile("" : "+s"(bid_));
        Ctx c; c.tid = tid_; c.lane = tid_ & 63; c.wave = __builtin_amdgcn_readfirstlane(tid_ >> 6); c.b = bid_; c.G = gridDim.x; c.lds = shm;
        const __attribute__((address_space(4))) Params* kp = (const __attribute__((address_space(4))) Params*)__builtin_amdgcn_kernarg_segment_ptr();
        asm volatile("" : "+s"(kp));
        run_phase(*kp, c, ph);
        if (ph + 1 < ph_hi) xcd_barrier(gbar);
    }
}

extern "C" void kernel_launch(void* const* d_in, const int* in_sizes, int n_in, void* d_out, int out_size, void* d_ws, size_t ws_size, hipStream_t stream) {
    static int grid = 0;
    if (grid == 0) {
        int dev = 0, cus = 0, per_cu = 0;
        (void)hipGetDevice(&dev); (void)hipDeviceGetAttribute(&cus, hipDeviceAttributeMultiprocessorCount, dev);
        (void)hipFuncSetAttribute((const void*)fwd_kernel, hipFuncAttributeMaxDynamicSharedMemorySize, LDS_BYTES);
        (void)hipOccupancyMaxActiveBlocksPerMultiprocessor(&per_cu, (const void*)fwd_kernel, NTHREADS, LDS_BYTES);
        (void)hipGetLastError();
        if (per_cu < 1) per_cu = 1;
        grid = cus;
        if (ws_size < WS_END) fprintf(stderr, "kernel_launch: workspace too small: %zu < %zu\n", ws_size, (size_t)WS_END);
        if (n_in != 46) fprintf(stderr, "kernel_launch: expected 46 inputs, got %d\n", n_in);
    }
    if (ws_size < WS_END || n_in != 46) return;
    Params p{};
    for (int i = 0; i < 46; ++i) p.in[i] = (const float*)d_in[i];
    p.out = (float*)d_out; p.ws = (unsigned char*)d_ws;
#if N_LAUNCH_MODE == 1
    (void)hipMemsetAsync((unsigned char*)d_ws + WS_BAR, 0, XCD_BAR_WORDS * 4, stream);
    int lo = 0, hi = N_PHASES;
    void* args[] = {&p, &lo, &hi};
    hipError_t e = hipLaunchCooperativeKernel((const void*)fwd_kernel, dim3(grid), dim3(NTHREADS), args, LDS_BYTES, stream);
    if (e != hipSuccess) fprintf(stderr, "cooperative launch failed: %s (grid %d)\n", hipGetErrorString(e), grid);
#else
    for (int ph = 0; ph < N_PHASES; ++ph) hipLaunchKernelGGL(fwd_kernel, dim3(grid), dim3(NTHREADS), LDS_BYTES, stream, p, ph, ph + 1);
#endif
}
```
